# Optimizing an MI355X kernel written in HIP

```python
import jax, jax.numpy as jnp
from jax import lax
import numpy as np

D_MODEL = 1024
BATCH = 16
SEQ = 2048
DEPTH = 2

D_MIX = D_MODEL
N_MIXERS = 4
GROUP_W = D_MIX // N_MIXERS
HEAD_DIM = 64
N_HEADS_GROUP = GROUP_W // HEAD_DIM
QK_SCALE = HEAD_DIM ** -0.5
POOL_WINDOWS = (2, 4, 8, 16)
POOL_CH = GROUP_W // len(POOL_WINDOWS)
MAX_WINDOW = 16
RWKV_DECAY_LORA = 64
RWKV_A_LORA = 64
RWKV_GATE_LORA = 128
RWKV_COLS = 3 * GROUP_W + RWKV_DECAY_LORA + RWKV_A_LORA + RWKV_GATE_LORA
RWKV_GN_EPS = 64e-5
GLA_GATE_LORA = 16
GLA_GATE_TAU = 16.0
GLA_COLS = 4 * GROUP_W + GLA_GATE_LORA
CHUNK = 64
D_IN = GROUP_W + 4 * GROUP_W + RWKV_COLS + GLA_COLS
D_FF = 2816
NORM_EPS = 1e-6
GATE_FLOOR = 1e-30

kernel_name = 'hymba_style_pool_hgrn2_rwkv7_gla_macaron'


def rms_norm(x, g, eps=NORM_EPS):
    xf = x.astype(jnp.float32)
    y = xf * lax.rsqrt(jnp.mean(xf * xf, axis=-1, keepdims=True) + eps)
    return (y * g.astype(jnp.float32)).astype(x.dtype)


def swiglu_ffn(x, w_in, w_out):
    gate, up = jnp.split(x @ w_in, 2, axis=-1)
    return (jax.nn.silu(gate) * up) @ w_out


def split_heads(t):
    return t.reshape(t.shape[:-1] + (N_HEADS_GROUP, HEAD_DIM))


def causal_multiscale_pool(p, w_pool, b_pool, scale):
    B, T, _ = p.shape
    cs = jnp.pad(jnp.cumsum(p, axis=1), ((0, 0), (MAX_WINDOW, 0), (0, 0)))
    pos = jnp.arange(T)
    pooled = []
    for gi, w in enumerate(POOL_WINDOWS):
        lo, hi = gi * POOL_CH, (gi + 1) * POOL_CH
        win_sum = cs[:, MAX_WINDOW:, lo:hi] - cs[:, MAX_WINDOW - w:MAX_WINDOW - w + T, lo:hi]
        count = jnp.minimum(pos + 1, w).astype(jnp.float32)[None, :, None]
        pooled.append(win_sum / count)
    pooled = jnp.stack(pooled, axis=2) - p.reshape(B, T, len(POOL_WINDOWS), POOL_CH)
    y = jnp.einsum('btgc,gcd->btgd', pooled, w_pool).reshape(B, T, GROUP_W) + b_pool
    return y * scale


def chunked_gated_linear_attention(q, k, v, log_a):
    B, T, H, K = q.shape
    V = v.shape[-1]
    n = T // CHUNK

    def to_chunks(t):
        return t.reshape(B, n, CHUNK, H, t.shape[-1]).transpose(1, 0, 3, 2, 4)

    causal = jnp.tril(jnp.ones((CHUNK, CHUNK), dtype=bool))[:, :, None]

    def step(S, inp):
        qc, kc, vc, gc = inp
        b = jnp.cumsum(gc, axis=-2)
        diff = b[:, :, :, None, :] - b[:, :, None, :, :]
        decay = jnp.where(causal, jnp.exp(jnp.where(causal, diff, 0.0)), 0.0)
        scores = jnp.einsum('bhtk,bhsk,bhtsk->bhts', qc, kc, decay)
        o = jnp.einsum('bhts,bhsv->bhtv', scores, vc) + jnp.einsum('bhtk,bhkv->bhtv', qc * jnp.exp(b), S)
        b_last = b[:, :, -1:, :]
        S_new = jnp.exp(b_last[:, :, 0, :])[..., None] * S + jnp.einsum('bhsk,bhsv->bhkv', kc * jnp.exp(b_last - b), vc)
        return S_new, o

    S0 = jnp.zeros((B, H, K, V), jnp.float32)
    _, o = lax.scan(step, S0, (to_chunks(q), to_chunks(k), to_chunks(v), to_chunks(log_a)))
    return o.transpose(1, 0, 3, 2, 4).reshape(B, T, H, V)


def rwkv7_scan(r, w, k, v, kk, a):
    B, T, H, N = r.shape

    def step(S, inp):
        r_t, w_t, k_t, v_t, kk_t, a_t = inp
        s_kk = jnp.einsum('bhvk,bhk->bhv', S, kk_t)
        S = (S * w_t[:, :, None, :] - s_kk[..., None] * (kk_t * a_t)[:, :, None, :]
             + v_t[..., :, None] * k_t[:, :, None, :])
        return S, jnp.einsum('bhvk,bhk->bhv', S, r_t)

    xs = tuple(jnp.moveaxis(t, 1, 0) for t in (r, w, k, v, kk, a))
    S0 = jnp.zeros((B, H, N, N), jnp.float32)
    _, out = lax.scan(step, S0, xs)
    return jnp.moveaxis(out, 0, 1)


def token_mixer(u, w_in, w_out, pool_w, pool_b, pool_scale, lb, hgrn_norm,
                rwkv_mu, rwkv_w0, rwkv_w2, rwkv_a0, rwkv_a2, rwkv_g2, rwkv_k_k, rwkv_k_a,
                rwkv_r_k, rwkv_ln_w, rwkv_ln_b, gla_w2, gla_b, gla_norm):
    B, T, _ = u.shape
    G = GROUP_W
    p = (u @ w_in).astype(jnp.float32)
    p_pool, p_hg, p_rw, p_gla = jnp.split(p, [G, 5 * G, 5 * G + RWKV_COLS], axis=-1)

    y_pool = causal_multiscale_pool(p_pool, pool_w, pool_b, pool_scale)

    hq, hf, hi, hg = jnp.split(p_hg, 4, axis=-1)
    f = lb + (1.0 - lb) * jax.nn.sigmoid(hf)
    log_f = jnp.log(jnp.maximum(f, GATE_FLOOR))
    o_h = chunked_gated_linear_attention(split_heads(jax.nn.silu(hq) * QK_SCALE),
                                         split_heads(1.0 - f),
                                         split_heads(hi), split_heads(log_f)).reshape(B, T, G)
    y_hgrn = rms_norm(o_h, hgrn_norm) * jax.nn.sigmoid(hg)

    prev = jnp.pad(p_rw, ((0, 0), (1, 0), (0, 0)))[:, :T]
    p_rw = p_rw + (prev - p_rw) * rwkv_mu
    rr, rk, rv, xw, xa, xg = jnp.split(
        p_rw, [G, 2 * G, 3 * G, 3 * G + RWKV_DECAY_LORA, 3 * G + RWKV_DECAY_LORA + RWKV_A_LORA], axis=-1)
    w_log = -jax.nn.softplus(-(rwkv_w0 + jnp.tanh(xw) @ rwkv_w2)) - 0.5
    decay = jnp.exp(-jnp.exp(w_log))
    a = jax.nn.sigmoid(rwkv_a0 + xa @ rwkv_a2)
    g_r = jax.nn.sigmoid(xg) @ rwkv_g2
    kk = split_heads(rk * rwkv_k_k)
    kk = kk / jnp.maximum(jnp.sqrt(jnp.sum(kk * kk, axis=-1, keepdims=True)), 1e-12)
    rk = rk * (1.0 + (a - 1.0) * rwkv_k_a)
    r_h, k_h, v_h = split_heads(rr), split_heads(rk), split_heads(rv)
    o_r = rwkv7_scan(r_h, split_heads(decay), k_h, v_h, kk, split_heads(a))
    mu = jnp.mean(o_r, axis=-1, keepdims=True)
    var = jnp.mean(jnp.square(o_r - mu), axis=-1, keepdims=True)
    gn = ((o_r - mu) * lax.rsqrt(var + RWKV_GN_EPS)).reshape(B, T, G) * rwkv_ln_w + rwkv_ln_b
    bonus = (jnp.sum(r_h * k_h * split_heads(rwkv_r_k), axis=-1, keepdims=True) * v_h).reshape(B, T, G)
    y_rwkv = (gn + bonus) * g_r

    gq, gk, gv, gg, ga = jnp.split(p_gla, [G, 2 * G, 3 * G, 4 * G], axis=-1)
    log_a = jax.nn.log_sigmoid(ga @ gla_w2 + gla_b) / GLA_GATE_TAU
    o_g = chunked_gated_linear_attention(split_heads(gq * QK_SCALE), split_heads(gk),
                                         split_heads(gv), split_heads(log_a))
    o_g = (o_g * lax.rsqrt(jnp.mean(o_g * o_g, axis=-1, keepdims=True) + NORM_EPS)).reshape(B, T, G)
    y_gla = o_g * gla_norm * jax.nn.silu(gg)

    y = jnp.concatenate([y_pool, y_hgrn, y_rwkv, y_gla], axis=-1).astype(u.dtype)
    return y @ w_out


def setup_inputs(seed: int = 0) -> dict:
    key = jax.random.key(seed)
    ks = jax.random.split(key, 32)
    f32 = jnp.float32
    L, D, G = DEPTH, D_MODEL, GROUP_W

    def dense(k, shape, fan_in):
        return jax.random.normal(k, shape, f32) * fan_in ** -0.5

    def gain(k, shape):
        return 1.0 + 0.1 * jax.random.normal(k, shape, f32)

    def small(k, shape, s):
        return s * jax.random.normal(k, shape, f32)

    return {
        'x': jax.random.normal(ks[0], (BATCH, SEQ, D), f32),
        'norm_ffn1': gain(ks[1], (L, D)),
        'ffn1_w_in': dense(ks[2], (L, D, 2 * D_FF), D),
        'ffn1_w_out': dense(ks[3], (L, D_FF, D), D_FF),
        'norm_mix': gain(ks[4], (L, D)),
        'w_in': dense(ks[5], (L, D, D_IN), D),
        'w_out': dense(ks[6], (L, D_MIX, D), D_MIX),
        'pool_w': dense(ks[7], (L, len(POOL_WINDOWS), POOL_CH, POOL_CH), POOL_CH),
        'pool_b': small(ks[8], (L, G), 0.01),
        'pool_scale': gain(ks[9], (L, G)),
        'hgrn_lb_logits': small(ks[10], (L, G), 0.5),
        'hgrn_norm': gain(ks[11], (L, G)),
        'rwkv_mu': jax.random.uniform(ks[12], (L, RWKV_COLS), f32),
        'rwkv_w0': jax.random.uniform(ks[13], (L, G), f32, -4.0, 0.0),
        'rwkv_w2': dense(ks[14], (L, RWKV_DECAY_LORA, G), RWKV_DECAY_LORA),
        'rwkv_a0': small(ks[15], (L, G), 0.5),
        'rwkv_a2': dense(ks[16], (L, RWKV_A_LORA, G), RWKV_A_LORA),
        'rwkv_g2': dense(ks[17], (L, RWKV_GATE_LORA, G), RWKV_GATE_LORA),
        'rwkv_k_k': 0.85 + small(ks[18], (L, G), 0.1),
        'rwkv_k_a': gain(ks[19], (L, G)),
        'rwkv_r_k': small(ks[20], (L, G), 0.1),
        'rwkv_ln_w': gain(ks[21], (L, G)),
        'rwkv_ln_b': small(ks[22], (L, G), 0.01),
        'gla_w2': dense(ks[23], (L, GLA_GATE_LORA, G), GLA_GATE_LORA),
        'gla_b': small(ks[24], (L, G), 0.5),
        'gla_norm': gain(ks[25], (L, G)),
        'norm_ffn2': gain(ks[26], (L, D)),
        'ffn2_w_in': dense(ks[27], (L, D, 2 * D_FF), D),
        'ffn2_w_out': dense(ks[28], (L, D_FF, D), D_FF),
        'norm_final': gain(ks[29], (D,)),
    }


def reference(x, norm_ffn1, ffn1_w_in, ffn1_w_out, norm_mix, w_in, w_out, pool_w, pool_b,
              pool_scale, hgrn_lb_logits, hgrn_norm, rwkv_mu, rwkv_w0, rwkv_w2, rwkv_a0, rwkv_a2,
              rwkv_g2, rwkv_k_k, rwkv_k_a, rwkv_r_k, rwkv_ln_w, rwkv_ln_b, gla_w2, gla_b, gla_norm,
              norm_ffn2, ffn2_w_in, ffn2_w_out, norm_final):
    sm = jax.nn.softmax(hgrn_lb_logits.astype(jnp.float32), axis=0)
    lower_bounds = jnp.cumsum(sm, axis=0) - sm[0]
    for l in range(DEPTH):
        x = x + 0.5 * swiglu_ffn(rms_norm(x, norm_ffn1[l]), ffn1_w_in[l], ffn1_w_out[l])
        x = x + token_mixer(rms_norm(x, norm_mix[l]), w_in[l], w_out[l], pool_w[l], pool_b[l],
                            pool_scale[l], lower_bounds[l], hgrn_norm[l], rwkv_mu[l], rwkv_w0[l],
                            rwkv_w2[l], rwkv_a0[l], rwkv_a2[l], rwkv_g2[l], rwkv_k_k[l], rwkv_k_a[l],
                            rwkv_r_k[l], rwkv_ln_w[l], rwkv_ln_b[l], gla_w2[l], gla_b[l], gla_norm[l])
        x = x + 0.5 * swiglu_ffn(rms_norm(x, norm_ffn2[l]), ffn2_w_in[l], ffn2_w_out[l])
    return rms_norm(x, norm_final)
```

```cpp
#include <hip/hip_runtime.h>
#include <cstdio>
#include <cstdint>
namespace pg8 {
#define PG8_LAS __attribute__((address_space(3)))
typedef unsigned short bf16_t;
typedef short bf16x8 __attribute__((ext_vector_type(8)));
typedef float f32x4 __attribute__((ext_vector_type(4)));
typedef unsigned u32x4 __attribute__((ext_vector_type(4)));
constexpr int BM = 256, BK = 64, HALF = 128, HTB = HALF * BK * 2  , STAGE_BYTES = 8 * HTB, NXCD = 8, WGM = 8;

__host__ __device__ __forceinline__ int lds_byte(int r, int c) { const int st = (r >> 4) * 2 + (c >> 5), rr = r & 15, cc = c & 31, ob = rr * 64 + cc * 2; return st * 1024 + (ob ^ (((ob >> 9) & 1) << 5)); }
__host__ __device__ __forceinline__ void stage_rc(int b, int& R, int& C) { const int st = b / 1024, sb = b % 1024, swz = sb ^ (((sb >> 9) & 1) << 5); R = (st >> 1) * 16 + swz / 64; C = (st & 1) * 32 + (swz % 64) / 2; }
__host__ __device__ __forceinline__ int perm32(int rho) { const int n = rho >> 4, i = rho & 15; return 8 * (i >> 2) + 4 * n + (i & 3); }

struct Unit { int pm, pn; };
struct Gemm { const bf16_t* A; const bf16_t* Bt; int M, N, K; };

struct StaticOrder {
    int nM, nN, nwg, G, c;
    __host__ __device__ void init(int M, int N, int G_, int c_) { nM = M / BM; nN = N / BM; nwg = nM * nN; G = G_; c = c_; }
    __host__ __device__ bool next(int i, Unit& u) const {
        const long L = (long)i * G + c; if (L >= nwg) return false;
        int wgid = (int)L; { const int q = nwg / NXCD, r = nwg % NXCD, xcd = wgid % NXCD, off = wgid / NXCD; wgid = (xcd < r ? xcd * (q + 1) : r * (q + 1) + (xcd - r) * q) + off; }
        const int nig = WGM * nN, gid = wgid / nig, fm = gid * WGM, gsz = (nM - fm) < WGM ? (nM - fm) : WGM;
        u.pm = fm + ((wgid % nig) % gsz); u.pn = (wgid % nig) / gsz; return true;
    }
    __device__ __forceinline__ void a_ready(const Unit&) const {}
    __device__ __forceinline__ void done(const Unit&) const {}
};
__device__ __forceinline__ unsigned cvt_pk_bf16(float lo, float hi) { unsigned r; asm volatile("v_cvt_pk_bf16_f32 %0, %1, %2" : "=v"(r) : "v"(lo), "v"(hi)); return r; }
typedef float f32x2 __attribute__((ext_vector_type(2)));
__device__ __forceinline__ float row_rstd(const float* ss, int row) {
    const f32x4* p = (const f32x4*)(ss + (size_t)row * 16);
    const f32x4 a = p[0], b = p[1], c = p[2], d = p[3];
    const float s = (((a[0] + a[1]) + (a[2] + a[3])) + ((b[0] + b[1]) + (b[2] + b[3]))) + (((c[0] + c[1]) + (c[2] + c[3])) + ((d[0] + d[1]) + (d[2] + d[3])));
    return __builtin_amdgcn_rsqf(s * (1.0f / 1024.0f) + 1e-6f);
}
__device__ __forceinline__ float silu_f(float g) { return g * __builtin_amdgcn_rcpf(1.0f + __expf(-g)); }
struct EpiSwiGLU {
    static constexpr bool PERM = true, AFTER_DRAIN = false;
    bf16_t* H; int ldh; const float* ss;
    __device__ __forceinline__ void operator()(const f32x4 (&acc)[2][2][4][2], const Unit& u, int wr, int wc, int fr, int fq) const {
        const int row0 = u.pm * BM + wr * 64 + fr, col0 = u.pn * 128 + wc * 32 + 8 * fq;
#pragma unroll
        for (int ai = 0; ai < 2; ++ai)
#pragma unroll
            for (int m = 0; m < 4; ++m) { const int row = row0 + ai * HALF + m * 16; const float rs = row_rstd(ss, row);
                const f32x4 g0 = acc[ai][0][m][0] * rs, g1 = acc[ai][0][m][1] * rs, u0 = acc[ai][1][m][0] * rs, u1 = acc[ai][1][m][1] * rs;
                u32x4 w; w.x = cvt_pk_bf16(silu_f(g0[0]) * u0[0], silu_f(g0[1]) * u0[1]); w.y = cvt_pk_bf16(silu_f(g0[2]) * u0[2], silu_f(g0[3]) * u0[3]);
                w.z = cvt_pk_bf16(silu_f(g1[0]) * u1[0], silu_f(g1[1]) * u1[1]); w.w = cvt_pk_bf16(silu_f(g1[2]) * u1[2], silu_f(g1[3]) * u1[3]);
                *(u32x4*)(H + (size_t)row * ldh + col0) = w; }
    }
};
struct EpiScale {
    static constexpr bool PERM = true, AFTER_DRAIN = false;
    bf16_t* P; int ldp; const float* ss;
    __device__ __forceinline__ void operator()(const f32x4 (&acc)[2][2][4][2], const Unit& u, int wr, int wc, int fr, int fq) const {
        const int row0 = u.pm * BM + wr * 64 + fr, col0 = u.pn * BM + wc * 32 + 8 * fq;
#pragma unroll
        for (int ai = 0; ai < 2; ++ai)
#pragma unroll
            for (int m = 0; m < 4; ++m) { const int row = row0 + ai * HALF + m * 16; const float rs = row_rstd(ss, row);
#pragma unroll
                for (int bj = 0; bj < 2; ++bj) { const f32x4 v0 = acc[ai][bj][m][0] * rs, v1 = acc[ai][bj][m][1] * rs;
                    u32x4 w; w.x = cvt_pk_bf16(v0[0], v0[1]); w.y = cvt_pk_bf16(v0[2], v0[3]); w.z = cvt_pk_bf16(v1[0], v1[1]); w.w = cvt_pk_bf16(v1[2], v1[3]);
                    *(u32x4*)(P + (size_t)row * ldp + col0 + bj * HALF) = w; } }
    }
};
struct EpiResid {
    static constexpr bool PERM = true, AFTER_DRAIN = false;
    const float* base; float* out; bf16_t* xb; float* ss; float scale;
    __device__ __forceinline__ void operator()(const f32x4 (&acc)[2][2][4][2], const Unit& u, int wr, int wc, int fr, int fq) const {
        const int row0 = u.pm * BM + wr * 64 + fr, col0 = u.pn * BM + wc * 32 + 8 * fq;
#pragma unroll
        for (int ai = 0; ai < 2; ++ai)
#pragma unroll
            for (int m = 0; m < 4; ++m) { const int row = row0 + ai * HALF + m * 16; const size_t off = (size_t)row * 1024 + col0; float sq = 0.f;
#pragma unroll
                for (int bj = 0; bj < 2; ++bj) {
                    const f32x4 b0 = *(const f32x4*)(base + off + bj * HALF), b1 = *(const f32x4*)(base + off + bj * HALF + 4);
                    const f32x4 v0 = b0 + acc[ai][bj][m][0] * scale, v1 = b1 + acc[ai][bj][m][1] * scale;
                    *(f32x4*)(out + off + bj * HALF) = v0; *(f32x4*)(out + off + bj * HALF + 4) = v1;
                    u32x4 w; w.x = cvt_pk_bf16(v0[0], v0[1]); w.y = cvt_pk_bf16(v0[2], v0[3]); w.z = cvt_pk_bf16(v1[0], v1[1]); w.w = cvt_pk_bf16(v1[2], v1[3]);
                    *(u32x4*)(xb + off + bj * HALF) = w;
                    sq += ((v0[0] * v0[0] + v0[1] * v0[1]) + (v0[2] * v0[2] + v0[3] * v0[3])) + ((v1[0] * v1[0] + v1[1] * v1[1]) + (v1[2] * v1[2] + v1[3] * v1[3])); }
                sq += __shfl_xor(sq, 16); sq += __shfl_xor(sq, 32);
                if (fq == 0) ss[(size_t)row * 16 + u.pn * 4 + wc] = sq; }
    }
};
template <class Epi, class Sched, bool ALIGN_EPI = false, bool SP2 = false>
__device__ __forceinline__ void gemm_phase(PG8_LAS unsigned char* lds, const Gemm g, const Sched& S, const Epi& E) {
    int tid_ = threadIdx.x; asm volatile("" : "+v"(tid_));
    const int tid = tid_, wid = __builtin_amdgcn_readfirstlane(tid >> 6), lane = tid & 63, wr = wid >> 2, wc = wid & 3, fr = lane & 15, fq = lane >> 4;
    const int K = g.K, nt = K / BK;
    unsigned voffA[2], voffB[2];
#pragma unroll
    for (int i = 0; i < 2; ++i) { int R, C; stage_rc(tid * 16 + i * 8192, R, C); const int Rb = Epi::PERM ? ((R & ~31) + perm32(R & 31)) : R;
        voffA[i] = (unsigned)(R * K + C) * 2u; voffB[i] = (unsigned)(Rb * K + C) * 2u; }
    const size_t kstep = (size_t)(BK * 2);
    const size_t hstep = (size_t)HALF * K * 2;
    const size_t tstep = 2 * hstep;
    const unsigned ldsw = (unsigned)wid * 1024u;
    const int aoff = lds_byte(wr * 64 + fr, fq * 8), boff = lds_byte(wc * 32 + fr, fq * 8);
#define PG8_SA(b, h) (((b) * 2 + (h)) * HTB)
#define PG8_SB(b, h) ((4 + (b) * 2 + (h)) * HTB)
#define PG8_STAGE(bufoff, gbase, voff) do { _Pragma("unroll") for (int _i = 0; _i < 2; ++_i) \
        __builtin_amdgcn_global_load_lds((const unsigned*)((const char*)(gbase) + (voff)[_i]), (PG8_LAS unsigned*)(lds + (bufoff) + ldsw + _i * 8192), 16, 0, 0); } while (0)
#define PG8_LDA(dst, b, h) do { _Pragma("unroll") for (int m = 0; m < 4; ++m) _Pragma("unroll") for (int k = 0; k < 2; ++k) dst[m][k] = *(const PG8_LAS bf16x8*)(lds + PG8_SA(b, h) + aoff + m * 2048 + k * 1024); } while (0)
#define PG8_LDB(dst, b, h) do { _Pragma("unroll") for (int n = 0; n < 2; ++n) _Pragma("unroll") for (int k = 0; k < 2; ++k) dst[n][k] = *(const PG8_LAS bf16x8*)(lds + PG8_SB(b, h) + boff + n * 2048 + k * 1024); } while (0)
#define PG8_MMA(ai, bj, At, Bt) do { __builtin_amdgcn_s_setprio(1); _Pragma("unroll") for (int m = 0; m < 4; ++m) _Pragma("unroll") for (int n = 0; n < 2; ++n) _Pragma("unroll") for (int k = 0; k < 2; ++k) \
        acc[ai][bj][m][n] = __builtin_amdgcn_mfma_f32_16x16x32_bf16(Bt[n][k], At[m][k], acc[ai][bj][m][n], 0, 0, 0); __builtin_amdgcn_s_setprio(0); } while (0)
#define PG8_WAIT_V(n) asm volatile("s_waitcnt vmcnt(" #n ")" ::: "memory")
#define PG8_WAIT_L(n) asm volatile("s_waitcnt lgkmcnt(" #n ")" ::: "memory")
#define PG8_BAR __builtin_amdgcn_s_barrier()
#define PG8_SCHED __builtin_amdgcn_sched_barrier(0)
    Unit cur, nxt; int ui = 0;
    if (!S.next(0, cur)) return;
    f32x4 acc[2][2][4][2];
#pragma unroll
    for (int a = 0; a < 2; ++a)
#pragma unroll
        for (int b = 0; b < 2; ++b)
#pragma unroll
            for (int m = 0; m < 4; ++m)
#pragma unroll
                for (int n = 0; n < 2; ++n) acc[a][b][m][n] = (f32x4){0.f, 0.f, 0.f, 0.f};
    bf16x8 At[4][2], B0[2][2], B1[2][2];
    const char* cA = (const char*)g.A + (size_t)cur.pm * tstep; const char* cB = (const char*)g.Bt + (size_t)cur.pn * tstep;
    S.a_ready(cur);
    if constexpr (SP2) {
        PG8_STAGE(PG8_SB(0, 0), cB, voffB); PG8_STAGE(PG8_SB(0, 1), cB + hstep, voffB); PG8_STAGE(PG8_SA(0, 0), cA, voffA); PG8_STAGE(PG8_SA(0, 1), cA + hstep, voffA);
        if (wr == 1) PG8_BAR;
        PG8_WAIT_V(2); PG8_BAR;
        PG8_STAGE(PG8_SB(1, 0), cB + kstep, voffB); PG8_STAGE(PG8_SA(1, 0), cA + kstep, voffA); PG8_STAGE(PG8_SB(1, 1), cB + hstep + kstep, voffB);
        PG8_WAIT_V(6); PG8_BAR;
    } else {
        PG8_STAGE(PG8_SB(0, 0), cB, voffB); PG8_STAGE(PG8_SA(0, 0), cA, voffA); PG8_STAGE(PG8_SB(0, 1), cB + hstep, voffB); PG8_STAGE(PG8_SA(0, 1), cA + hstep, voffA);
        if (wr == 1) PG8_BAR;
        PG8_WAIT_V(4); PG8_BAR;
        PG8_STAGE(PG8_SB(1, 0), cB + kstep, voffB); PG8_STAGE(PG8_SA(1, 0), cA + kstep, voffA); PG8_STAGE(PG8_SB(1, 1), cB + hstep + kstep, voffB);
        PG8_WAIT_V(6); PG8_BAR;
    }
    for (;;) {
        const bool has_next = S.next(ui + 1, nxt);
        const char* nA = has_next ? (const char*)g.A + (size_t)nxt.pm * tstep : cA; const char* nB = has_next ? (const char*)g.Bt + (size_t)nxt.pn * tstep : cB;
        for (int t = 0; t < nt; t += 2) {
            const bool last = (t == nt - 2);
            const char* a1 = cA + (size_t)(t + 1) * kstep;
            const char* a2 = last ? nA : cA + (size_t)(t + 2) * kstep; const char* b2 = last ? nB : cB + (size_t)(t + 2) * kstep;
            const char* a3 = a2 + kstep; const char* b3 = b2 + kstep;
            if (last && has_next) S.a_ready(nxt);
            if constexpr (SP2) {
            PG8_LDB(B0, 0, 0); PG8_LDB(B1, 0, 1); PG8_SCHED; PG8_LDA(At, 0, 0); PG8_STAGE(PG8_SA(1, 1), a1 + hstep, voffA);
            PG8_WAIT_V(8); PG8_WAIT_L(0); PG8_BAR; PG8_MMA(0, 0, At, B0); PG8_MMA(0, 1, At, B1); PG8_BAR; PG8_SCHED;
            PG8_LDA(At, 0, 1); PG8_STAGE(PG8_SB(0, 0), b2, voffB); PG8_STAGE(PG8_SB(0, 1), b2 + hstep, voffB); PG8_STAGE(PG8_SA(0, 0), a2, voffA);
            PG8_WAIT_V(8); PG8_WAIT_L(0); PG8_BAR; PG8_MMA(1, 0, At, B0); PG8_MMA(1, 1, At, B1); PG8_BAR; PG8_SCHED;
            PG8_LDB(B0, 1, 0); PG8_LDB(B1, 1, 1); PG8_SCHED; PG8_LDA(At, 1, 0); PG8_STAGE(PG8_SA(0, 1), a2 + hstep, voffA);
            PG8_WAIT_V(8); PG8_WAIT_L(0); PG8_BAR; PG8_MMA(0, 0, At, B0); PG8_MMA(0, 1, At, B1); PG8_BAR; PG8_SCHED;
            PG8_LDA(At, 1, 1); PG8_STAGE(PG8_SB(1, 0), b3, voffB); PG8_STAGE(PG8_SB(1, 1), b3 + hstep, voffB); PG8_STAGE(PG8_SA(1, 0), a3, voffA);
            PG8_WAIT_V(8); PG8_WAIT_L(0); PG8_BAR; PG8_MMA(1, 0, At, B0); PG8_MMA(1, 1, At, B1); PG8_BAR; PG8_SCHED;
            } else {
            PG8_LDB(B0, 0, 0); PG8_SCHED; PG8_LDA(At, 0, 0); PG8_STAGE(PG8_SA(1, 1), a1 + hstep, voffA);
            PG8_WAIT_L(8); PG8_BAR; PG8_WAIT_L(0); PG8_MMA(0, 0, At, B0); PG8_BAR; PG8_SCHED;
            PG8_LDB(B1, 0, 1); PG8_STAGE(PG8_SB(0, 0), b2, voffB);
            PG8_BAR; PG8_WAIT_L(0); PG8_MMA(0, 1, At, B1); PG8_BAR;
            PG8_LDA(At, 0, 1); PG8_STAGE(PG8_SA(0, 0), a2, voffA);
            PG8_BAR; PG8_WAIT_L(0); PG8_MMA(1, 0, At, B0); PG8_BAR; PG8_SCHED;
            PG8_STAGE(PG8_SB(0, 1), b2 + hstep, voffB);
            PG8_WAIT_V(6); PG8_BAR; PG8_MMA(1, 1, At, B1); PG8_BAR;
            PG8_LDB(B0, 1, 0); PG8_SCHED; PG8_LDA(At, 1, 0); PG8_STAGE(PG8_SA(0, 1), a2 + hstep, voffA);
            PG8_WAIT_L(8); PG8_BAR; PG8_WAIT_L(0); PG8_MMA(0, 0, At, B0); PG8_BAR; PG8_SCHED;
            PG8_LDB(B1, 1, 1); PG8_STAGE(PG8_SB(1, 0), b3, voffB);
            PG8_BAR; PG8_WAIT_L(0); PG8_MMA(0, 1, At, B1); PG8_BAR;
            PG8_LDA(At, 1, 1); PG8_STAGE(PG8_SA(1, 0), a3, voffA);
            PG8_BAR; PG8_WAIT_L(0); PG8_MMA(1, 0, At, B0); PG8_BAR; PG8_SCHED;
            PG8_STAGE(PG8_SB(1, 1), b3 + hstep, voffB);
            PG8_WAIT_V(6); PG8_BAR; PG8_MMA(1, 1, At, B1); PG8_BAR;
            }
        }
        if constexpr (ALIGN_EPI) { if (wr == 0) PG8_BAR; }
        if constexpr (!Epi::AFTER_DRAIN) { E(acc, cur, wr, wc, fr, fq); S.done(cur); }
        if (!has_next) break;
#pragma unroll
        for (int a = 0; a < 2; ++a)
#pragma unroll
            for (int b = 0; b < 2; ++b)
#pragma unroll
                for (int m = 0; m < 4; ++m)
#pragma unroll
                    for (int n = 0; n < 2; ++n) acc[a][b][m][n] = (f32x4){0.f, 0.f, 0.f, 0.f};
        cur = nxt; cA = nA; cB = nB; ++ui;
        if constexpr (ALIGN_EPI) { if (wr == 1) PG8_BAR; }
    }
    PG8_WAIT_V(0);
    if constexpr (!ALIGN_EPI) { if (wr == 0) PG8_BAR; }
    PG8_BAR;
    if constexpr (Epi::AFTER_DRAIN) { E.fused(acc, cur, wr, wc, fr, fq, lds, wid, lane); S.done(cur); }
#undef PG8_SA
#undef PG8_SB
#undef PG8_STAGE
#undef PG8_LDA
#undef PG8_LDB
#undef PG8_MMA
#undef PG8_WAIT_V
#undef PG8_WAIT_L
#undef PG8_BAR
#undef PG8_SCHED
}
}
#define GAS __attribute__((address_space(1)))
#define LAS __attribute__((address_space(3)))
typedef unsigned short bf16;
typedef unsigned v4u __attribute__((ext_vector_type(4)));
typedef float f32x4 __attribute__((ext_vector_type(4)));
typedef short bf16x8 __attribute__((ext_vector_type(8)));
typedef GAS unsigned gu32;
typedef GAS unsigned long long gu64;
#define RLX_AGENT __ATOMIC_RELAXED, __HIP_MEMORY_SCOPE_AGENT
#define LDS_WAIT() asm volatile("s_waitcnt lgkmcnt(0)" ::: "memory")
#define VM_WAIT() asm volatile("s_waitcnt vmcnt(0)" ::: "memory")
__device__ __forceinline__ unsigned long long rt() { return __builtin_amdgcn_s_memrealtime(); }
__device__ __forceinline__ unsigned f2bf(float f) { unsigned u = __builtin_bit_cast(unsigned, f); return (u + 0x7fffu + ((u >> 16) & 1u)) >> 16; }
__device__ __forceinline__ unsigned pk2(float lo, float hi) { return f2bf(lo) | (f2bf(hi) << 16); }

#define XB_TMO      128
#define XB_XCNT(j)  (256  + 64 * (j))
#define XB_XSUB(j)  (1280 + 64 * (j))
#define XB_XGEN(j)  (2304 + 64 * (j))
#define XB_TOP      3328
#define XB_TOPGEN   3392
#define XCD_BAR_WORDS 3456
#define XB_SPIN_CAP (1u << 18)

__device__ __forceinline__ unsigned xb_ld(unsigned* p)              { return __hip_atomic_load(p, __ATOMIC_RELAXED, __HIP_MEMORY_SCOPE_AGENT); }
__device__ __forceinline__ unsigned xb_add(unsigned* p, unsigned v) { return __hip_atomic_fetch_add(p, v, __ATOMIC_RELAXED, __HIP_MEMORY_SCOPE_AGENT); }
__device__ __forceinline__ unsigned xb_xcc_id() { return (unsigned)__builtin_amdgcn_s_getreg((3 << 11) | 20) & 0xFu; }
#define XB_SPIN(cond, bar) do { unsigned _sp = 0; while (cond) { __builtin_amdgcn_s_sleep(1); \
    if ((++_sp & 255u) == 0u) { if (xb_ld(&(bar)[XB_TMO])) break; if (_sp > XB_SPIN_CAP) { atomicAdd(&(bar)[XB_TMO], 1u); break; } } } } while (0)

struct XcdBarrier {
    unsigned* bar; unsigned x;
    volatile LAS unsigned* st;
};

__device__ __forceinline__ XcdBarrier xcd_barrier_post(unsigned* bar, volatile LAS unsigned* st) {
    XcdBarrier b; b.bar = bar; b.x = xb_xcc_id(); b.st = st;
    if (threadIdx.x == 0) (void)xb_add(&bar[XB_XCNT(b.x)], 1u);
    return b;
}
__device__ __forceinline__ void xcd_barrier_complete(unsigned* bar, unsigned x, unsigned& nloc, unsigned& nx) {
    const unsigned G = gridDim.x * gridDim.y * gridDim.z;
    unsigned sum, cnt, mine, sp = 0u;
    for (;;) {
        sum = 0u; cnt = 0u; mine = 0u;
#pragma unroll
        for (unsigned j = 0; j < 16; ++j) { const unsigned c = xb_ld(&bar[XB_XCNT(j)]); sum += c; cnt += (c > 0u) ? 1u : 0u; mine = (j == x) ? c : mine; }
        if (sum == G) break;
        __builtin_amdgcn_s_sleep(1);
        if ((++sp & 255u) == 0u) { if (xb_ld(&bar[XB_TMO])) break; if (sp > XB_SPIN_CAP) { atomicAdd(&bar[XB_TMO], 1u); break; } }
    }
    nloc = mine > 0u ? mine : 1u; nx = cnt > 0u ? cnt : 1u;
}

__device__ __forceinline__ void xcd_barrier(const XcdBarrier& b) {
    asm volatile("s_waitcnt vmcnt(0)" ::: "memory");
    __syncthreads();
    if (threadIdx.x == 0) {
        unsigned* bar = b.bar;
        __builtin_amdgcn_s_waitcnt(0);
        unsigned nloc = b.st[0], nx = b.st[1];
        if (nloc == 0u) { xcd_barrier_complete(bar, b.x, nloc, nx); b.st[0] = nloc; b.st[1] = nx; }
        const unsigned old = xb_add(&bar[XB_XSUB(b.x)], 1u);
        const unsigned gen = old / nloc;
        if (old + 1u == (gen + 1u) * nloc) {
            __builtin_amdgcn_fence(__ATOMIC_RELEASE, "agent");
            asm volatile("s_waitcnt vmcnt(0)" ::: "memory");
            const unsigned og = xb_add(&bar[XB_TOP], 1u);
            const unsigned tg = og / nx;
            if (og + 1u == (tg + 1u) * nx) xb_add(&bar[XB_TOPGEN], 1u);
            else XB_SPIN(xb_ld(&bar[XB_TOPGEN]) == tg, bar);
            __builtin_amdgcn_fence(__ATOMIC_ACQUIRE, "agent");
            xb_add(&bar[XB_XGEN(b.x)], 1u);
            asm volatile("s_waitcnt vmcnt(0)" ::: "memory");
        } else {
            XB_SPIN(xb_ld(&bar[XB_XGEN(b.x)]) == gen, bar);
            __builtin_amdgcn_fence(__ATOMIC_ACQUIRE, "agent");
            asm volatile("s_waitcnt vmcnt(0)" ::: "memory");
        }
    }
    __syncthreads();
}
constexpr int NWAVES = 8;
constexpr int NL = 2, NB = 16, NT = 2048, D = 1024, DFF = 2816, M = NB * NT;
constexpr int DIN = 3344, NP = 3584;
constexpr int PC_POOL = 0, PC_HG = 256, PC_RW = 1280, PC_RWX = 2048, PC_GL = 2304;
constexpr int N_PHASES = 18;
constexpr size_t MiB = 1u << 20;
constexpr size_t WS_CTL = 0, CTL_ZERO_BYTES = 64 * 1024;
constexpr size_t WS_SS = 1 * MiB;
constexpr size_t WS_W = 4 * MiB, W_LAYER = 42 * MiB;
constexpr size_t WO_1IN = 0, WO_1OUT = 11 * MiB, WO_IN = 16 * MiB + MiB / 2, WO_OUT = 23 * MiB + MiB / 2, WO_2IN = 25 * MiB + MiB / 2, WO_2OUT = 36 * MiB + MiB / 2;
constexpr size_t WS_XB = 88 * MiB;
constexpr size_t WS_Y = 152 * MiB;
constexpr size_t WS_HP = 216 * MiB;
constexpr size_t WS_END = 440 * MiB;
static_assert(WO_2OUT + (size_t)D * DFF * 2 == W_LAYER && WS_W + NL * W_LAYER == WS_XB && WS_HP + (size_t)M * NP * 2 == WS_END, "d_ws map");
constexpr int CW_BAR = 1024;
constexpr int RING_OFF = 0, RING_BYTES = 131072;
constexpr int LDSCTL_OFF = RING_BYTES, MISC_OFF = LDSCTL_OFF + 320;
constexpr int LDS_BYTES = 147456;
struct Args { const float* in[30]; float* out; unsigned char* ws; int ph_lo, ph_hi; };
template <int I> __device__ __forceinline__ const float* kin() {
    const auto ka = __builtin_amdgcn_kernarg_segment_ptr(); const GAS float* p;
    asm volatile("s_load_dwordx2 %0, %1, %2\n\ts_waitcnt lgkmcnt(0)" : "=s"(p) : "s"(ka), "n"(I * 8) : "memory");
    return (const float*)p;
}
__device__ __forceinline__ int otid() { int t = threadIdx.x; asm volatile("" : "+v"(t)); return t; }
struct Frame {
    LAS unsigned char* lds; volatile LAS unsigned* MISC; gu32* ctl;
    int G, vcu;
    float* out; unsigned char* ws;
    bf16 *XB, *Y, *HP; float* SS;
};
__device__ __forceinline__ float wave_sum(float v) {
#pragma unroll
    for (int o = 1; o < 64; o <<= 1) v += __shfl_xor(v, o);
    return v;
}
__device__ __forceinline__ float bf_lo(unsigned u) { return __builtin_bit_cast(float, u << 16); }
__device__ __forceinline__ float bf_hi(unsigned u) { return __builtin_bit_cast(float, u & 0xffff0000u); }
__device__ __forceinline__ f32x4 ld_bf4(const bf16* p) { const uint2 u = *(const uint2*)p; return (f32x4){bf_lo(u.x), bf_hi(u.x), bf_lo(u.y), bf_hi(u.y)}; }
__device__ __forceinline__ void st_bf4(bf16* p, f32x4 v) { uint2 u; u.x = pk2(v[0], v[1]); u.y = pk2(v[2], v[3]); *(uint2*)p = u; }
using pg8::silu_f;
typedef unsigned u32x2 __attribute__((ext_vector_type(2)));
__device__ __forceinline__ float sigmoid_f(float x) { return __builtin_amdgcn_rcpf(1.0f + __expf(-x)); }
__device__ __forceinline__ float tanh_f(float x) { return 1.0f - 2.0f * __builtin_amdgcn_rcpf(__expf(2.0f * x) + 1.0f); }
template <int CTRL> __device__ __forceinline__ float dpp_f(float x) { return __builtin_bit_cast(float, __builtin_amdgcn_update_dpp(0, __builtin_bit_cast(int, x), CTRL, 0xF, 0xF, true)); }
__device__ __forceinline__ float red8(float x) { x += dpp_f<0xB1>(x); x += dpp_f<0x4E>(x); x += dpp_f<0x141>(x); return x; }
__device__ __forceinline__ float red16(float x) { x = red8(x); x += dpp_f<0x140>(x); return x; }

__device__ __forceinline__ void tr_item(const float* W, int ldw, int sc, const float* gain, const float* w2, bf16* WT, int K, int n0, int k0, LAS float* scr, int lane) {
    if (sc >= 0) {
#pragma unroll 8
        for (int i = 0; i < 32; ++i) { const int kk = 2 * i + (lane >> 5); float v = W[(size_t)(k0 + kk) * ldw + sc + (lane & 31)]; if (gain) v *= gain[k0 + kk]; scr[kk * 33 + (lane & 31)] = v; }
    } else {
        const int c = -1 - sc + (lane & 31);
        float wv[16];
#pragma unroll
        for (int i = 0; i < 16; ++i) wv[i] = w2[i * 256 + c];
#pragma unroll 2
        for (int i = 0; i < 32; ++i) { const int kk = 2 * i + (lane >> 5); const float* wr_ = W + (size_t)(k0 + kk) * ldw + 3328; float v = 0.f;
#pragma unroll
            for (int j = 0; j < 16; ++j) v += wr_[j] * wv[j];
            scr[kk * 33 + (lane & 31)] = v * gain[k0 + kk]; }
    }
    LDS_WAIT(); asm volatile("" ::: "memory");
    const int c = lane & 7;
#pragma unroll
    for (int j = 0; j < 4; ++j) { const int n = (lane >> 3) + 8 * j; const LAS float* s = scr + (8 * c) * 33 + n;
        v4u o; o.x = pk2(s[0 * 33], s[1 * 33]); o.y = pk2(s[2 * 33], s[3 * 33]); o.z = pk2(s[4 * 33], s[5 * 33]); o.w = pk2(s[6 * 33], s[7 * 33]);
        *(GAS v4u*)(WT + (size_t)(n0 + n) * K + k0 + 8 * c) = o; }
    LDS_WAIT(); asm volatile("" ::: "memory");
}
__device__ __forceinline__ int win_src_col(int n) {
    if (n < PC_HG) return n;
    if (n < PC_RW) { const int m = n - PC_HG, h = m >> 8, w = m & 255; return 256 + (w >> 6) * 256 + h * 64 + (w & 63); }
    if (n < PC_RWX) { const int m = n - PC_RW, h = m / 192, w = m % 192; return 1280 + (w >> 6) * 256 + h * 64 + (w & 63); }
    if (n < PC_GL) return n;
    { const int m = n - PC_GL, h = m / 320, w = m % 320, part = w >> 6, j = w & 63; if (part < 4) return 2304 + part * 256 + h * 64 + j; return -1 - (h * 64 + j); }
}
__device__ __forceinline__ void p0_prologue(Frame& F, const Args& A) {
    const int tid = otid(), lane = tid & 63, wave = __builtin_amdgcn_readfirstlane(tid >> 6);
    LAS float* scr = (LAS float*)(F.lds + RING_OFF + wave * 16384);
    const int gw = F.vcu * NWAVES + wave, NGW = F.G * NWAVES;
    constexpr int I_FIN = (D / 64) * (2 * DFF / 32), I_FOUT = (DFF / 64) * (D / 32), I_IN = (D / 64) * (NP / 32), I_OUT = (D / 64) * (D / 32);
    constexpr int I_LAYER = 2 * I_FIN + 2 * I_FOUT + I_IN + I_OUT;
    for (int it = gw; it < NL * I_LAYER; it += NGW) {
        const int l = it / I_LAYER; int r = it % I_LAYER;
        bf16* wl = (bf16*)(F.ws + WS_W + (size_t)l * W_LAYER);
        if (r < 2 * I_FIN) {
            const int which = r / I_FIN; r %= I_FIN; const int nblk = 2 * DFF / 32, kb = r / nblk, nb = r % nblk, n0 = 32 * nb, pn = n0 >> 8, w = n0 & 255;
            const int sc = (w < 128) ? 128 * pn + w : DFF + 128 * pn + (w - 128);
            tr_item((which ? kin<27>() : kin<2>()) + (size_t)l * D * 2 * DFF, 2 * DFF, sc, (which ? kin<26>() : kin<1>()) + l * D, nullptr, (bf16*)((char*)wl + (which ? WO_2IN : WO_1IN)), D, n0, 64 * kb, scr, lane);
            continue; }
        r -= 2 * I_FIN;
        if (r < 2 * I_FOUT) {
            const int which = r / I_FOUT; r %= I_FOUT; const int nblk = D / 32, kb = r / nblk, nb = r % nblk;
            tr_item((which ? kin<28>() : kin<3>()) + (size_t)l * DFF * D, D, 32 * nb, nullptr, nullptr, (bf16*)((char*)wl + (which ? WO_2OUT : WO_1OUT)), DFF, 32 * nb, 64 * kb, scr, lane);
            continue; }
        r -= 2 * I_FOUT;
        if (r < I_IN) {
            const int nblk = NP / 32, kb = r / nblk, nb = r % nblk;
            tr_item(kin<5>() + (size_t)l * D * DIN, DIN, win_src_col(32 * nb), kin<4>() + l * D, kin<23>() + l * 16 * 256, (bf16*)((char*)wl + WO_IN), D, 32 * nb, 64 * kb, scr, lane);
            continue; }
        r -= I_IN;
        { const int nblk = D / 32, kb = r / nblk, nb = r % nblk;
          tr_item(kin<6>() + (size_t)l * D * D, D, 32 * nb, nullptr, nullptr, (bf16*)((char*)wl + WO_OUT), D, 32 * nb, 64 * kb, scr, lane); }
    }
    const float* x = kin<0>();
    for (int m = gw; m < M; m += NGW) {
        const GAS f32x4* xr = (const GAS f32x4*)(x + (size_t)m * D) + lane; f32x4 v[4]; float s = 0.f;
#pragma unroll
        for (int j = 0; j < 4; ++j) { v[j] = xr[64 * j]; s += (v[j][0] * v[j][0] + v[j][1] * v[j][1]) + (v[j][2] * v[j][2] + v[j][3] * v[j][3]); }
        s = wave_sum(s);
        GAS unsigned long long* o8 = (GAS unsigned long long*)(F.XB + (size_t)m * D) + lane;
#pragma unroll
        for (int j = 0; j < 4; ++j) o8[64 * j] = (unsigned long long)pk2(v[j][0], v[j][1]) | ((unsigned long long)pk2(v[j][2], v[j][3]) << 32);
        if (lane < 16) F.SS[(size_t)m * 16 + lane] = (lane == 0) ? s : 0.f;
    }
}
constexpr int SC = 32;
constexpr int LA_BYTES = SC * 64 * 4;
constexpr int L_XW = 8 * LA_BYTES, L_XA = L_XW + SC * 144, L_XG = L_XA + SC * 144, L_W2T = L_XG + SC * 272, L_A2T = L_W2T + 64 * 144, L_G2T = L_A2T + 64 * 144, L_SCAN_END = L_G2T + 64 * 272;
static_assert(L_SCAN_END <= RING_BYTES, "scan LDS map");
__device__ __forceinline__ f32x4 mfma16(bf16x8 a, bf16x8 b, f32x4 c) { return __builtin_amdgcn_mfma_f32_16x16x32_bf16(a, b, c, 0, 0, 0); }

__device__ __forceinline__ void scan_gla(const LAS float* A_, const LAS float* KX, const LAS float* Q, const LAS float* V, LAS float* O, float (&S)[8], int wave, int lane) {
    const int ks = lane & 7, v = wave * 8 + (lane >> 3);
#pragma unroll 4
    for (int t = 0; t < SC; ++t) {
        const f32x4 a0 = *(const LAS f32x4*)(A_ + t * 64 + ks * 8), a1 = *(const LAS f32x4*)(A_ + t * 64 + ks * 8 + 4);
        const f32x4 k0 = *(const LAS f32x4*)(KX + t * 64 + ks * 8), k1 = *(const LAS f32x4*)(KX + t * 64 + ks * 8 + 4);
        const f32x4 q0 = *(const LAS f32x4*)(Q + t * 64 + ks * 8), q1 = *(const LAS f32x4*)(Q + t * 64 + ks * 8 + 4);
        const float vv = V[t * 64 + v];
        float o = 0.f;
#pragma unroll
        for (int j = 0; j < 4; ++j) { S[j] = a0[j] * S[j] + k0[j] * vv; S[4 + j] = a1[j] * S[4 + j] + k1[j] * vv; o += q0[j] * S[j] + q1[j] * S[4 + j]; }
        o = red8(o);
        if (ks == 0) O[t * 64 + v] = o;
    }
}
__device__ __forceinline__ void scan_rwkv(const LAS float* W_, const LAS float* KK, const LAS float* KA, const LAS float* KX, const LAS float* R, const LAS float* V, LAS float* O, float (&S)[8], int wave, int lane) {
    const int ks = lane & 7, v = wave * 8 + (lane >> 3);
#pragma unroll 2
    for (int t = 0; t < SC; ++t) {
        const int o8 = t * 64 + ks * 8;
        const f32x4 w0 = *(const LAS f32x4*)(W_ + o8), w1 = *(const LAS f32x4*)(W_ + o8 + 4);
        const f32x4 c0 = *(const LAS f32x4*)(KK + o8), c1 = *(const LAS f32x4*)(KK + o8 + 4);
        const f32x4 e0 = *(const LAS f32x4*)(KA + o8), e1 = *(const LAS f32x4*)(KA + o8 + 4);
        const f32x4 k0 = *(const LAS f32x4*)(KX + o8), k1 = *(const LAS f32x4*)(KX + o8 + 4);
        const f32x4 r0 = *(const LAS f32x4*)(R + o8), r1 = *(const LAS f32x4*)(R + o8 + 4);
        const float vv = V[t * 64 + v];
        float d = 0.f;
#pragma unroll
        for (int j = 0; j < 4; ++j) d += S[j] * c0[j] + S[4 + j] * c1[j];
        d = red8(d);
        float o = 0.f;
#pragma unroll
        for (int j = 0; j < 4; ++j) { S[j] = S[j] * w0[j] + (vv * k0[j] - d * e0[j]); S[4 + j] = S[4 + j] * w1[j] + (vv * k1[j] - d * e1[j]); o += S[j] * r0[j] + S[4 + j] * r1[j]; }
        o = red8(o);
        if (ks == 0) O[t * 64 + v] = o;
    }
}

template <int MIX> __device__ __forceinline__ void glalike_item(Frame& F, const Args& A, int l, int b, int h) {
    LAS float* fA = (LAS float*)(F.lds + 0 * LA_BYTES); LAS float* fKX = (LAS float*)(F.lds + 3 * LA_BYTES); LAS float* fQ = (LAS float*)(F.lds + 4 * LA_BYTES);
    LAS float* fV = (LAS float*)(F.lds + 5 * LA_BYTES); LAS float* fO = (LAS float*)(F.lds + 6 * LA_BYTES);
    const int tid = otid(), lane = tid & 63, wave = __builtin_amdgcn_readfirstlane(tid >> 6);
    const int t = tid >> 4, j = tid & 15, ch = h * 64 + 4 * j;
    const int pc = (MIX == 0) ? PC_HG + h * 256 : PC_GL + h * 320;
    f32x4 cst0, cst1;
    if (MIX == 0) { if (l == 0) cst0 = (f32x4){0.f, 0.f, 0.f, 0.f}; else { const f32x4 z0 = *(const f32x4*)(kin<10>() + ch), z1 = *(const f32x4*)(kin<10>() + 256 + ch);
#pragma unroll
            for (int i = 0; i < 4; ++i) cst0[i] = __builtin_amdgcn_rcpf(1.0f + __expf(z0[i] - z1[i])); } cst1 = cst0; }
    else { cst0 = *(const f32x4*)(kin<24>() + l * 256 + ch); cst1 = *(const f32x4*)(kin<25>() + l * 256 + ch); }
    float S[8];
#pragma unroll
    for (int i = 0; i < 8; ++i) S[i] = 0.f;
    for (int c = 0; c < NT / SC; ++c) {
        const size_t row = (size_t)b * NT + c * SC + t; const bf16* pr = F.HP + row * NP + pc + 4 * j;
        const f32x4 xq = ld_bf4(pr), x1 = ld_bf4(pr + 64), xv = ld_bf4(pr + 128);
        f32x4 va, vk, vq;
        if (MIX == 0) {
#pragma unroll
            for (int i = 0; i < 4; ++i) { const float f = cst0[i] + (1.0f - cst0[i]) * sigmoid_f(x1[i]); va[i] = f; vk[i] = 1.0f - f; vq[i] = silu_f(xq[i]) * 0.125f; }
        } else {
            const f32x4 ga = ld_bf4(pr + 256);
#pragma unroll
            for (int i = 0; i < 4; ++i) { const float x = ga[i] + cst0[i]; const float ls = fminf(x, 0.f) - __logf(1.0f + __expf(-fabsf(x))); va[i] = __expf(ls * 0.0625f); vk[i] = x1[i]; vq[i] = xq[i] * 0.125f; }
        }
        *(LAS f32x4*)(fA + t * 64 + 4 * j) = va; *(LAS f32x4*)(fKX + t * 64 + 4 * j) = vk; *(LAS f32x4*)(fQ + t * 64 + 4 * j) = vq; *(LAS f32x4*)(fV + t * 64 + 4 * j) = xv;
        __syncthreads();
        scan_gla(fA, fKX, fQ, fV, fO, S, wave, lane);
        __syncthreads();
        const f32x4 o = *(const LAS f32x4*)(fO + t * 64 + 4 * j);
        if (MIX == 0) st_bf4(F.Y + row * D + 256 + ch, o);
        else { const float ms = red16((o[0] * o[0] + o[1] * o[1]) + (o[2] * o[2] + o[3] * o[3])) * (1.0f / 64.0f); const float rs = __builtin_amdgcn_rsqf(ms + 1e-6f);
            const f32x4 gg = ld_bf4(pr + 192); f32x4 y;
#pragma unroll
            for (int i = 0; i < 4; ++i) y[i] = o[i] * rs * cst1[i] * silu_f(gg[i]);
            st_bf4(F.Y + row * D + 768 + ch, y); }
    }
    __syncthreads();
}

__device__ __forceinline__ void rwkv_item(Frame& F, const Args& A, int l, int b, int h) {
    LAS float* fW = (LAS float*)(F.lds + 0 * LA_BYTES); LAS float* fKK = (LAS float*)(F.lds + 1 * LA_BYTES); LAS float* fKA = (LAS float*)(F.lds + 2 * LA_BYTES); LAS float* fKX = (LAS float*)(F.lds + 3 * LA_BYTES);
    LAS float* fR = (LAS float*)(F.lds + 4 * LA_BYTES); LAS float* fV = (LAS float*)(F.lds + 5 * LA_BYTES); LAS float* fO = (LAS float*)(F.lds + 6 * LA_BYTES); LAS float* fG = (LAS float*)(F.lds + 7 * LA_BYTES);
    LAS bf16* sXW = (LAS bf16*)(F.lds + L_XW); LAS bf16* sXA = (LAS bf16*)(F.lds + L_XA); LAS bf16* sXG = (LAS bf16*)(F.lds + L_XG);
    LAS bf16* sW2 = (LAS bf16*)(F.lds + L_W2T); LAS bf16* sA2 = (LAS bf16*)(F.lds + L_A2T); LAS bf16* sG2 = (LAS bf16*)(F.lds + L_G2T);
    const int tid = otid(), lane = tid & 63, wave = __builtin_amdgcn_readfirstlane(tid >> 6), t = tid >> 4, j = tid & 15, ch = h * 64 + 4 * j;
    for (int i = tid; i < 64 * 64; i += NWAVES * 64) { const int k = i >> 6, n = i & 63;
        sW2[n * 72 + k] = (bf16)f2bf(kin<14>()[((size_t)l * 64 + k) * 256 + h * 64 + n]); sA2[n * 72 + k] = (bf16)f2bf(kin<16>()[((size_t)l * 64 + k) * 256 + h * 64 + n]); }
    for (int i = tid; i < 128 * 64; i += NWAVES * 64) { const int k = i >> 6, n = i & 63; sG2[n * 136 + k] = (bf16)f2bf(kin<17>()[((size_t)l * 128 + k) * 256 + h * 64 + n]); }
    const float* mu = kin<12>() + l * 1024;
    const f32x4 mu_r = *(const f32x4*)(mu + ch), mu_k = *(const f32x4*)(mu + 256 + ch), mu_v = *(const f32x4*)(mu + 512 + ch);
    const f32x4 mu_w = *(const f32x4*)(mu + 768 + 4 * j), mu_a = *(const f32x4*)(mu + 832 + 4 * j), mu_g0 = *(const f32x4*)(mu + 896 + 8 * j), mu_g1 = *(const f32x4*)(mu + 900 + 8 * j);
    const f32x4 c_kk = *(const f32x4*)(kin<18>() + l * 256 + ch), c_ka = *(const f32x4*)(kin<19>() + l * 256 + ch), c_rk = *(const f32x4*)(kin<20>() + l * 256 + ch);
    const f32x4 c_lw = *(const f32x4*)(kin<21>() + l * 256 + ch), c_lb = *(const f32x4*)(kin<22>() + l * 256 + ch);
    const int mt = wave >> 2, nt = wave & 3, fr = lane & 15, fq = lane >> 4;
    const float w0n = kin<13>()[l * 256 + h * 64 + nt * 16 + fr], a0n = kin<15>()[l * 256 + h * 64 + nt * 16 + fr];
    float S[8];
#pragma unroll
    for (int i = 0; i < 8; ++i) S[i] = 0.f;
    __syncthreads();
    for (int c = 0; c < NT / SC; ++c) {
        const int tpos = c * SC + t; const size_t row = (size_t)b * NT + tpos;
        const bf16* cur = F.HP + row * NP; const bf16* prv = (tpos > 0) ? cur - NP : cur; const float pm = (tpos > 0) ? 1.0f : 0.0f;
        {
            const bf16* ph = cur + PC_RW + h * 192 + 4 * j; const bf16* pp = prv + PC_RW + h * 192 + 4 * j;
            const f32x4 r = ld_bf4(ph), k = ld_bf4(ph + 64), v = ld_bf4(ph + 128);
            const f32x4 rp = ld_bf4(pp) * pm, kp = ld_bf4(pp + 64) * pm, vp = ld_bf4(pp + 128) * pm;
            *(LAS f32x4*)(fR + t * 64 + 4 * j) = r + (rp - r) * mu_r; *(LAS f32x4*)(fKX + t * 64 + 4 * j) = k + (kp - k) * mu_k; *(LAS f32x4*)(fV + t * 64 + 4 * j) = v + (vp - v) * mu_v;
            const f32x4 xw = ld_bf4(cur + PC_RWX + 4 * j), xwp = ld_bf4(prv + PC_RWX + 4 * j) * pm, xa = ld_bf4(cur + PC_RWX + 64 + 4 * j), xap = ld_bf4(prv + PC_RWX + 64 + 4 * j) * pm;
            const f32x4 sw = xw + (xwp - xw) * mu_w, sa = xa + (xap - xa) * mu_a;
            u32x2 u; u.x = pk2(tanh_f(sw[0]), tanh_f(sw[1])); u.y = pk2(tanh_f(sw[2]), tanh_f(sw[3])); *(LAS u32x2*)(sXW + t * 72 + 4 * j) = u;
            u.x = pk2(sa[0], sa[1]); u.y = pk2(sa[2], sa[3]); *(LAS u32x2*)(sXA + t * 72 + 4 * j) = u;
            const f32x4 g0 = ld_bf4(cur + PC_RWX + 128 + 8 * j), g1 = ld_bf4(cur + PC_RWX + 132 + 8 * j), g0p = ld_bf4(prv + PC_RWX + 128 + 8 * j) * pm, g1p = ld_bf4(prv + PC_RWX + 132 + 8 * j) * pm;
            const f32x4 s0 = g0 + (g0p - g0) * mu_g0, s1 = g1 + (g1p - g1) * mu_g1;
            v4u w; w.x = pk2(sigmoid_f(s0[0]), sigmoid_f(s0[1])); w.y = pk2(sigmoid_f(s0[2]), sigmoid_f(s0[3])); w.z = pk2(sigmoid_f(s1[0]), sigmoid_f(s1[1])); w.w = pk2(sigmoid_f(s1[2]), sigmoid_f(s1[3]));
            *(LAS v4u*)(sXG + t * 136 + 8 * j) = w;
        }
        __syncthreads();
        {
            f32x4 cw = {0.f, 0.f, 0.f, 0.f}, ca = cw, cg = cw;
#pragma unroll
            for (int ks = 0; ks < 2; ++ks) {
                cw = mfma16(*(const LAS bf16x8*)(sXW + (mt * 16 + fr) * 72 + ks * 32 + fq * 8), *(const LAS bf16x8*)(sW2 + (nt * 16 + fr) * 72 + ks * 32 + fq * 8), cw);
                ca = mfma16(*(const LAS bf16x8*)(sXA + (mt * 16 + fr) * 72 + ks * 32 + fq * 8), *(const LAS bf16x8*)(sA2 + (nt * 16 + fr) * 72 + ks * 32 + fq * 8), ca); }
#pragma unroll
            for (int ks = 0; ks < 4; ++ks) cg = mfma16(*(const LAS bf16x8*)(sXG + (mt * 16 + fr) * 136 + ks * 32 + fq * 8), *(const LAS bf16x8*)(sG2 + (nt * 16 + fr) * 136 + ks * 32 + fq * 8), cg);
            const int n = nt * 16 + fr;
#pragma unroll
            for (int rg = 0; rg < 4; ++rg) { const int tt = mt * 16 + fq * 4 + rg;
                fW[tt * 64 + n] = __expf(-0.6065306597f * sigmoid_f(w0n + cw[rg]));
                fO[tt * 64 + n] = sigmoid_f(a0n + ca[rg]);
                fG[tt * 64 + n] = cg[rg]; }
        }
        __syncthreads();
        {
            const f32x4 rk = *(const LAS f32x4*)(fKX + t * 64 + 4 * j), a = *(const LAS f32x4*)(fO + t * 64 + 4 * j);
            const f32x4 kr = rk * c_kk; const float n2 = red16((kr[0] * kr[0] + kr[1] * kr[1]) + (kr[2] * kr[2] + kr[3] * kr[3]));
            const float inv = 1.0f / fmaxf(sqrtf(n2), 1e-12f); const f32x4 kk = kr * inv;
            *(LAS f32x4*)(fKK + t * 64 + 4 * j) = kk; *(LAS f32x4*)(fKA + t * 64 + 4 * j) = kk * a;
            f32x4 kx;
#pragma unroll
            for (int i = 0; i < 4; ++i) kx[i] = rk[i] * (1.0f + (a[i] - 1.0f) * c_ka[i]);
            *(LAS f32x4*)(fKX + t * 64 + 4 * j) = kx;
        }
        __syncthreads();
        scan_rwkv(fW, fKK, fKA, fKX, fR, fV, fO, S, wave, lane);
        __syncthreads();
        {
            const f32x4 o = *(const LAS f32x4*)(fO + t * 64 + 4 * j), r = *(const LAS f32x4*)(fR + t * 64 + 4 * j), kx = *(const LAS f32x4*)(fKX + t * 64 + 4 * j);
            const f32x4 v = *(const LAS f32x4*)(fV + t * 64 + 4 * j), g = *(const LAS f32x4*)(fG + t * 64 + 4 * j);
            const float mean = red16((o[0] + o[1]) + (o[2] + o[3])) * (1.0f / 64.0f); const f32x4 dv = o - mean;
            const float var = red16((dv[0] * dv[0] + dv[1] * dv[1]) + (dv[2] * dv[2] + dv[3] * dv[3])) * (1.0f / 64.0f); const float rs = __builtin_amdgcn_rsqf(var + 64e-5f);
            const float bon = red16((r[0] * kx[0] * c_rk[0] + r[1] * kx[1] * c_rk[1]) + (r[2] * kx[2] * c_rk[2] + r[3] * kx[3] * c_rk[3]));
            f32x4 y;
#pragma unroll
            for (int i = 0; i < 4; ++i) y[i] = (dv[i] * rs * c_lw[i] + c_lb[i] + bon * v[i]) * g[i];
            st_bf4(F.Y + row * D + 512 + ch, y);
        }
        __syncthreads();
    }
}

constexpr int L_PX = 0, L_PL = 40960, L_PW = L_PL + 64 * 4 * 72 * 2, L_POOL_END = L_PW + 4 * 64 * 72 * 2;
static_assert(79 * 512 <= L_PL && L_POOL_END <= RING_BYTES, "pool LDS map");
__device__ __forceinline__ void pool_item(Frame& F, const Args& A, int l, int b, int c) {
    LAS bf16* PX = (LAS bf16*)(F.lds + L_PX); LAS bf16* PL = (LAS bf16*)(F.lds + L_PL); LAS bf16* PW = (LAS bf16*)(F.lds + L_PW);
    const int tid = otid(), lane = tid & 63, wave = __builtin_amdgcn_readfirstlane(tid >> 6), t0 = c * 64;
    for (int i = tid; i < 79 * 32; i += NWAVES * 64) { const int r = i >> 5, cc = i & 31, tok = t0 - 15 + r;
        v4u v = {0u, 0u, 0u, 0u}; if (tok >= 0) v = *(const v4u*)(F.HP + ((size_t)b * NT + tok) * NP + PC_POOL + cc * 8);
        *(LAS v4u*)(PX + r * 256 + cc * 8) = v; }
    const float* pw = kin<7>() + (size_t)l * 4 * 64 * 64;
    for (int i = tid; i < 4 * 64 * 64; i += NWAVES * 64) { const int g = i >> 12, cc = (i >> 6) & 63, d = i & 63; PW[(g * 64 + d) * 72 + cc] = (bf16)f2bf(pw[i]); }
    __syncthreads();
    {
        const int t = tid >> 3, g = (tid >> 1) & 3, half = tid & 1, w = 2 << g, col = g * 64 + half * 32;
        const int cntn = (t0 + t + 1 < w) ? (t0 + t + 1) : w; const float rc = 1.0f / (float)cntn;
        f32x4 acc[8];
#pragma unroll
        for (int q = 0; q < 8; ++q) acc[q] = (f32x4){0.f, 0.f, 0.f, 0.f};
        for (int s = 0; s < w; ++s) {
#pragma unroll
            for (int q = 0; q < 4; ++q) { const v4u u = *(const LAS v4u*)(PX + (15 + t - s) * 256 + col + 8 * q);
                acc[2 * q] += (f32x4){bf_lo(u.x), bf_hi(u.x), bf_lo(u.y), bf_hi(u.y)}; acc[2 * q + 1] += (f32x4){bf_lo(u.z), bf_hi(u.z), bf_lo(u.w), bf_hi(u.w)}; } }
#pragma unroll
        for (int q = 0; q < 4; ++q) { const v4u u = *(const LAS v4u*)(PX + (15 + t) * 256 + col + 8 * q);
            const f32x4 p0 = acc[2 * q] * rc - (f32x4){bf_lo(u.x), bf_hi(u.x), bf_lo(u.y), bf_hi(u.y)}, p1 = acc[2 * q + 1] * rc - (f32x4){bf_lo(u.z), bf_hi(u.z), bf_lo(u.w), bf_hi(u.w)};
            v4u o; o.x = pk2(p0[0], p0[1]); o.y = pk2(p0[2], p0[3]); o.z = pk2(p1[0], p1[1]); o.w = pk2(p1[2], p1[3]);
            *(LAS v4u*)(PL + (t * 4 + g) * 72 + half * 32 + 8 * q) = o; }
    }
    __syncthreads();
    {
        const int g = wave & 3, mh = wave >> 2, fr = lane & 15, fq = lane >> 4;
        const float* pb = kin<8>() + l * 256 + g * 64; const float* ps = kin<9>() + l * 256 + g * 64;
#pragma unroll
        for (int mt = 0; mt < 2; ++mt)
#pragma unroll
            for (int nt = 0; nt < 4; ++nt) { f32x4 acc = {0.f, 0.f, 0.f, 0.f};
#pragma unroll
                for (int ks = 0; ks < 2; ++ks) acc = mfma16(*(const LAS bf16x8*)(PL + ((mh * 32 + mt * 16 + fr) * 4 + g) * 72 + ks * 32 + fq * 8), *(const LAS bf16x8*)(PW + (g * 64 + nt * 16 + fr) * 72 + ks * 32 + fq * 8), acc);
                const int d = nt * 16 + fr; const float bb = pb[d], sc = ps[d];
#pragma unroll
                for (int rg = 0; rg < 4; ++rg) { const int t = mh * 32 + mt * 16 + fq * 4 + rg; F.Y[((size_t)b * NT + t0 + t) * D + g * 64 + d] = (bf16)f2bf((acc[rg] + bb) * sc); } }
    }
    __syncthreads();
}
__device__ __forceinline__ void mixer_phase(Frame& F, const Args& A, int l) {
    constexpr int NSCAN = 3 * NB * 4, NPOOL = NB * (NT / 64);
    for (int it = blockIdx.x; it < NSCAN + NPOOL; it += F.G) {
        if (it < NSCAN) { const int mix = it >> 6, b = (it & 63) >> 2, h = it & 3;
            if (mix == 0) rwkv_item(F, A, l, b, h); else if (mix == 1) glalike_item<0>(F, A, l, b, h); else glalike_item<2>(F, A, l, b, h); }
        else { const int r = it - NSCAN; pool_item(F, A, l, r >> 5, r & 31); }
    }
}
__device__ __forceinline__ void hgrn_post(Frame& F, const Args& A, int l) {
    const int tid = otid(), lane = tid & 63, wave = __builtin_amdgcn_readfirstlane(tid >> 6);
    const int gw = blockIdx.x * NWAVES + wave, NGW = F.G * NWAVES, c = 4 * lane;
    const f32x4 gn = *(const f32x4*)(kin<11>() + l * 256 + c);
    for (int m = gw; m < M; m += NGW) {
        bf16* yp = F.Y + (size_t)m * D + 256 + c; const f32x4 o = ld_bf4(yp);
        const float ms = wave_sum((o[0] * o[0] + o[1] * o[1]) + (o[2] * o[2] + o[3] * o[3])) * (1.0f / 256.0f); const float rs = __builtin_amdgcn_rsqf(ms + 1e-6f);
        const f32x4 hg = ld_bf4(F.HP + (size_t)m * NP + PC_HG + (c >> 6) * 256 + 192 + (c & 63)); f32x4 y;
#pragma unroll
        for (int i = 0; i < 4; ++i) y[i] = o[i] * rs * gn[i] * sigmoid_f(hg[i]);
        st_bf4(yp, y);
    }
}
__device__ __forceinline__ void final_norm(Frame& F, const Args& A) {
    const int tid = otid(), lane = tid & 63, wave = __builtin_amdgcn_readfirstlane(tid >> 6);
    const int gw = blockIdx.x * NWAVES + wave, NGW = F.G * NWAVES;
    f32x4 g[4];
#pragma unroll
    for (int j = 0; j < 4; ++j) g[j] = *((const f32x4*)kin<29>() + lane + 64 * j);
    for (int m = gw; m < M; m += NGW) { const float rs = pg8::row_rstd(F.SS, m); GAS f32x4* xr = (GAS f32x4*)(F.out + (size_t)m * D) + lane;
#pragma unroll
        for (int j = 0; j < 4; ++j) xr[64 * j] = xr[64 * j] * rs * g[j]; }
}
#ifndef MK_N_LAUNCHES
#define MK_N_LAUNCHES 1
#endif
__global__ void __launch_bounds__(NWAVES * 64, 2) fwd(Args args) {
    extern __shared__ __attribute__((aligned(16))) unsigned char lds[];
    Frame F;
    F.lds = (LAS unsigned char*)lds; F.MISC = (volatile LAS unsigned*)(F.lds + MISC_OFF);
    F.G = gridDim.x; { const int bx = blockIdx.x; F.vcu = (F.G % 8 == 0) ? (bx % 8) * (F.G / 8) + bx / 8 : bx; }
    F.out = args.out; F.ws = args.ws; F.ctl = (gu32*)(args.ws + WS_CTL);
    F.XB = (bf16*)(args.ws + WS_XB); F.Y = (bf16*)(args.ws + WS_Y); F.HP = (bf16*)(args.ws + WS_HP); F.SS = (float*)(args.ws + WS_SS);
    for (int u = threadIdx.x; u < (LDS_BYTES - LDSCTL_OFF) / 4; u += NWAVES * 64) ((LAS unsigned*)(F.lds + LDSCTL_OFF))[u] = 0u;
    __syncthreads();
    const int lo = args.ph_lo, hi = args.ph_hi;
    XcdBarrier bar; bar.bar = (unsigned*)(F.ctl + CW_BAR); bar.x = 0; bar.st = nullptr;
    if (hi - lo > 1) bar = xcd_barrier_post((unsigned*)(F.ctl + CW_BAR), F.MISC + 8);
#define IN(k) (lo <= (k) && (k) < hi)
#define SEAM(k) do { if (IN(k) && IN((k) + 1)) xcd_barrier(bar); } while (0)
#ifndef PHMASK
#define PHMASK 0xFFFF
#endif
#define PHEN(k) ((PHMASK >> (k)) & 1)
    if (PHEN(0) && IN(0)) p0_prologue(F, args);
    SEAM(0);
    for (int l = 0; l < NL; ++l) {
        const int pb = 1 + 8 * l;
        const unsigned char* wl = args.ws + WS_W + (size_t)l * W_LAYER;
        if (PHEN(1) && IN(pb + 0)) {
            pg8::Gemm g{F.XB, (const bf16*)(wl + WO_1IN), M, 2 * DFF, D}; pg8::StaticOrder S; S.init(M, 2 * DFF, F.G, (int)blockIdx.x);
            pg8::EpiSwiGLU E{F.HP, DFF, F.SS};
            pg8::gemm_phase<pg8::EpiSwiGLU, pg8::StaticOrder, true, true>(F.lds + RING_OFF, g, S, E); }
        SEAM(pb + 0);
        if (PHEN(2) && IN(pb + 1)) {
            pg8::Gemm g{F.HP, (const bf16*)(wl + WO_1OUT), M, D, DFF}; pg8::StaticOrder S; S.init(M, D, F.G, (int)blockIdx.x);
            pg8::EpiResid E{l == 0 ? kin<0>() : (const float*)F.out, F.out, F.XB, F.SS, 0.5f};
            pg8::gemm_phase<pg8::EpiResid, pg8::StaticOrder, true, true>(F.lds + RING_OFF, g, S, E); }
        SEAM(pb + 1);
        if (PHEN(3) && IN(pb + 2)) {
            pg8::Gemm g{F.XB, (const bf16*)(wl + WO_IN), M, NP, D}; pg8::StaticOrder S; S.init(M, NP, F.G, (int)blockIdx.x);
            pg8::EpiScale E{F.HP, NP, F.SS};
            pg8::gemm_phase<pg8::EpiScale, pg8::StaticOrder, true, true>(F.lds + RING_OFF, g, S, E); }
        SEAM(pb + 2);
        if (PHEN(4) && IN(pb + 3)) mixer_phase(F, args, l);
        SEAM(pb + 3);
        if (PHEN(5) && IN(pb + 4)) hgrn_post(F, args, l);
        SEAM(pb + 4);
        if (PHEN(6) && IN(pb + 5)) {
            pg8::Gemm g{F.Y, (const bf16*)(wl + WO_OUT), M, D, D}; pg8::StaticOrder S; S.init(M, D, F.G, (int)blockIdx.x);
            pg8::EpiResid E{(const float*)F.out, F.out, F.XB, F.SS, 1.0f};
            pg8::gemm_phase<pg8::EpiResid, pg8::StaticOrder, true, true>(F.lds + RING_OFF, g, S, E); }
        SEAM(pb + 5);
        if (PHEN(7) && IN(pb + 6)) {
            pg8::Gemm g{F.XB, (const bf16*)(wl + WO_2IN), M, 2 * DFF, D}; pg8::StaticOrder S; S.init(M, 2 * DFF, F.G, (int)blockIdx.x);
            pg8::EpiSwiGLU E{F.HP, DFF, F.SS};
            pg8::gemm_phase<pg8::EpiSwiGLU, pg8::StaticOrder, true, true>(F.lds + RING_OFF, g, S, E); }
        SEAM(pb + 6);
        if (PHEN(8) && IN(pb + 7)) {
            pg8::Gemm g{F.HP, (const bf16*)(wl + WO_2OUT), M, D, DFF}; pg8::StaticOrder S; S.init(M, D, F.G, (int)blockIdx.x);
            pg8::EpiResid E{(const float*)F.out, F.out, F.XB, F.SS, 0.5f};
            pg8::gemm_phase<pg8::EpiResid, pg8::StaticOrder, true, true>(F.lds + RING_OFF, g, S, E); }
        SEAM(pb + 7);
    }
    if (PHEN(9) && IN(17)) final_norm(F, args);
#undef IN
#undef SEAM
}

extern "C" void kernel_launch(void* const* d_in, const int* in_sizes, int n_in, void* d_out, int out_size, void* d_ws, size_t ws_size, hipStream_t stream) {
    static int grid = 0;
    if (grid == 0) {
        if (n_in != 30 || in_sizes[0] != M * D || out_size != M * D || ws_size < WS_END) { fprintf(stderr, "kernel_launch: built for 30 inputs, x/out of %d floats, >= %zu bytes of workspace; got n_in %d, in0 %d, out %d, ws %zu; nothing launched\n", M * D, (size_t)WS_END, n_in, n_in > 0 ? in_sizes[0] : -1, out_size, ws_size); grid = -1; return; }
        int dev = 0, cus = 0, per_cu = 0;
        if (hipGetDevice(&dev) != hipSuccess || hipDeviceGetAttribute(&cus, hipDeviceAttributeMultiprocessorCount, dev) != hipSuccess) { fprintf(stderr, "kernel_launch: device query failed\n"); grid = -1; return; }
        if (hipFuncSetAttribute((const void*)fwd, hipFuncAttributeMaxDynamicSharedMemorySize, LDS_BYTES) != hipSuccess) { fprintf(stderr, "kernel_launch: hipFuncSetAttribute failed\n"); grid = -1; return; }
        if (hipOccupancyMaxActiveBlocksPerMultiprocessor(&per_cu, (const void*)fwd, NWAVES * 64, LDS_BYTES) != hipSuccess || per_cu < 1)
            fprintf(stderr, "kernel_launch: note: occupancy query reports %d workgroups per CU\n", per_cu);
        (void)hipGetLastError();
        grid = cus;
    }
    if (grid < 0) return;
    if (hipMemsetAsync((char*)d_ws + WS_CTL, 0, CTL_ZERO_BYTES, stream) != hipSuccess) { fprintf(stderr, "kernel_launch: memset failed\n"); return; }
    Args a{};
    for (int i = 0; i < 30; ++i) a.in[i] = (const float*)d_in[i];
    a.out = (float*)d_out; a.ws = (unsigned char*)d_ws;
    if (MK_N_LAUNCHES == 1) { a.ph_lo = 0; a.ph_hi = N_PHASES; hipLaunchKernelGGL(fwd, dim3(grid), dim3(NWAVES * 64), LDS_BYTES, stream, a); }
    else for (int k = 0; k < N_PHASES; ++k) { a.ph_lo = k; a.ph_hi = k + 1; hipLaunchKernelGGL(fwd, dim3(grid), dim3(NWAVES * 64), LDS_BYTES, stream, a); }
    const hipError_t le = hipPeekAtLastError();
    if (le != hipSuccess) fprintf(stderr, "kernel_launch: launch failed: %s\n", hipGetErrorName(le));
}
```

```cpp
#include <hip/hip_runtime.h>
#include <cstdio>
#include <cstdint>
namespace pg8 {
#define PG8_LAS __attribute__((address_space(3)))
typedef unsigned short bf16_t;
typedef short bf16x8 __attribute__((ext_vector_type(8)));
typedef float f32x4 __attribute__((ext_vector_type(4)));
typedef unsigned u32x4 __attribute__((ext_vector_type(4)));
constexpr int BM = 256, BK = 64, HALF = 128, HTB = HALF * BK * 2  , STAGE_BYTES = 8 * HTB, NXCD = 8, WGM = 8;

__host__ __device__ __forceinline__ int lds_byte(int r, int c) { const int st = (r >> 4) * 2 + (c >> 5), rr = r & 15, cc = c & 31, ob = rr * 64 + cc * 2; return st * 1024 + (ob ^ (((ob >> 9) & 1) << 5)); }
__host__ __device__ __forceinline__ void stage_rc(int b, int& R, int& C) { const int st = b / 1024, sb = b % 1024, swz = sb ^ (((sb >> 9) & 1) << 5); R = (st >> 1) * 16 + swz / 64; C = (st & 1) * 32 + (swz % 64) / 2; }
__host__ __device__ __forceinline__ int perm32(int rho) { const int n = rho >> 4, i = rho & 15; return 8 * (i >> 2) + 4 * n + (i & 3); }

struct Unit { int pm, pn; };
struct Gemm { const bf16_t* A; const bf16_t* Bt; int M, N, K; };

struct StaticOrder {
    int nM, nN, nwg, G, c;
    __host__ __device__ void init(int M, int N, int G_, int c_) { nM = M / BM; nN = N / BM; nwg = nM * nN; G = G_; c = c_; }
    __host__ __device__ bool next(int i, Unit& u) const {
        const long L = (long)i * G + c; if (L >= nwg) return false;
        int wgid = (int)L; { const int q = nwg / NXCD, r = nwg % NXCD, xcd = wgid % NXCD, off = wgid / NXCD; wgid = (xcd < r ? xcd * (q + 1) : r * (q + 1) + (xcd - r) * q) + off; }
        const int nig = WGM * nN, gid = wgid / nig, fm = gid * WGM, gsz = (nM - fm) < WGM ? (nM - fm) : WGM;
        u.pm = fm + ((wgid % nig) % gsz); u.pn = (wgid % nig) / gsz; return true;
    }
    __device__ __forceinline__ void a_ready(const Unit&) const {}
    __device__ __forceinline__ void done(const Unit&) const {}
};
typedef __bf16 bf16x2_cv __attribute__((ext_vector_type(2)));
__device__ __forceinline__ unsigned cvt_pk_bf16(float lo, float hi) { typedef float f32x2_cv __attribute__((ext_vector_type(2))); const f32x2_cv v = {lo, hi}; return __builtin_bit_cast(unsigned, __builtin_convertvector(v, bf16x2_cv)); }
typedef float f32x2 __attribute__((ext_vector_type(2)));
__device__ __forceinline__ float row_rstd(const float* ss, int row) {
    const f32x4* p = (const f32x4*)(ss + (size_t)row * 16);
    const f32x4 a = p[0], b = p[1], c = p[2], d = p[3];
    const float s = (((a[0] + a[1]) + (a[2] + a[3])) + ((b[0] + b[1]) + (b[2] + b[3]))) + (((c[0] + c[1]) + (c[2] + c[3])) + ((d[0] + d[1]) + (d[2] + d[3])));
    return __builtin_amdgcn_rsqf(s * (1.0f / 1024.0f) + 1e-6f);
}
__device__ __forceinline__ float silu_f(float g) { return g * __builtin_amdgcn_rcpf(1.0f + __expf(-g)); }
struct EpiSwiGLU {
    static constexpr bool PERM = true, AFTER_DRAIN = false, RSTD = true;
    bf16_t* H; int ldh; const float* ss; const PG8_LAS float* rstab;
    __device__ __forceinline__ void operator()(const f32x4 (&acc)[2][2][4][2], const Unit& u, int wr, int wc, int fr, int fq) const {
        const int row0 = u.pm * BM + wr * 64 + fr, col0 = u.pn * 128 + wc * 32 + 8 * fq;
#pragma unroll
        for (int ai = 0; ai < 2; ++ai)
#pragma unroll
            for (int m = 0; m < 4; ++m) { const int row = row0 + ai * HALF + m * 16; const float rs = rstab[ai * HALF + wr * 64 + m * 16 + fr];
                const float c1 = rs * -1.44269504f, rs2 = rs * rs; const f32x4 ga = acc[ai][0][m][0], gb = acc[ai][0][m][1], ua = acc[ai][1][m][0], ub = acc[ai][1][m][1];
                float t[8], p[8];
#pragma unroll
                for (int j = 0; j < 4; ++j) { t[j] = ga[j] * c1; t[4 + j] = gb[j] * c1; p[j] = ga[j] * ua[j]; p[4 + j] = gb[j] * ub[j]; }
#pragma unroll
                for (int j = 0; j < 8; ++j) t[j] = __builtin_amdgcn_exp2f(t[j]);
#pragma unroll
                for (int j = 0; j < 8; ++j) { t[j] = 1.0f + t[j]; p[j] *= rs2; }
#pragma unroll
                for (int j = 0; j < 8; ++j) t[j] = __builtin_amdgcn_rcpf(t[j]);
#pragma unroll
                for (int j = 0; j < 8; ++j) p[j] *= t[j];
                u32x4 w; w.x = cvt_pk_bf16(p[0], p[1]); w.y = cvt_pk_bf16(p[2], p[3]); w.z = cvt_pk_bf16(p[4], p[5]); w.w = cvt_pk_bf16(p[6], p[7]);
                *(u32x4*)(H + (size_t)row * ldh + col0) = w; }
    }
};
struct EpiScale {
    static constexpr bool PERM = true, AFTER_DRAIN = false, RSTD = true;
    bf16_t* P; int ldp; const float* ss; const PG8_LAS float* rstab;
    __device__ __forceinline__ void operator()(const f32x4 (&acc)[2][2][4][2], const Unit& u, int wr, int wc, int fr, int fq) const {
        const int row0 = u.pm * BM + wr * 64 + fr, col0 = u.pn * BM + wc * 32 + 8 * fq;
#pragma unroll
        for (int ai = 0; ai < 2; ++ai)
#pragma unroll
            for (int m = 0; m < 4; ++m) { const int row = row0 + ai * HALF + m * 16; const float rs = rstab[ai * HALF + wr * 64 + m * 16 + fr];
#pragma unroll
                for (int bj = 0; bj < 2; ++bj) { const f32x4 v0 = acc[ai][bj][m][0] * rs, v1 = acc[ai][bj][m][1] * rs;
                    u32x4 w; w.x = cvt_pk_bf16(v0[0], v0[1]); w.y = cvt_pk_bf16(v0[2], v0[3]); w.z = cvt_pk_bf16(v1[0], v1[1]); w.w = cvt_pk_bf16(v1[2], v1[3]);
                    *(u32x4*)(P + (size_t)row * ldp + col0 + bj * HALF) = w; } }
    }
};
struct EpiResid {
    static constexpr bool PERM = true, AFTER_DRAIN = false, RSTD = false;
    bf16_t* xb; float* ss; float scale;
    __device__ __forceinline__ void operator()(const f32x4 (&acc)[2][2][4][2], const Unit& u, int wr, int wc, int fr, int fq) const {
        const int row0 = u.pm * BM + wr * 64 + fr, col0 = u.pn * BM + wc * 32 + 8 * fq;
#pragma unroll
        for (int ai = 0; ai < 2; ++ai)
#pragma unroll
            for (int m = 0; m < 4; ++m) { const int row = row0 + ai * HALF + m * 16; const size_t off = (size_t)row * 1024 + col0; float sq = 0.f;
#pragma unroll
                for (int bj = 0; bj < 2; ++bj) {
                    const u32x4 b = *(const u32x4*)(xb + off + bj * HALF);
                    const f32x4 b0 = {__builtin_bit_cast(float, b.x << 16), __builtin_bit_cast(float, b.x & 0xffff0000u), __builtin_bit_cast(float, b.y << 16), __builtin_bit_cast(float, b.y & 0xffff0000u)};
                    const f32x4 b1 = {__builtin_bit_cast(float, b.z << 16), __builtin_bit_cast(float, b.z & 0xffff0000u), __builtin_bit_cast(float, b.w << 16), __builtin_bit_cast(float, b.w & 0xffff0000u)};
                    const f32x4 v0 = b0 + acc[ai][bj][m][0] * scale, v1 = b1 + acc[ai][bj][m][1] * scale;
                    u32x4 w; w.x = cvt_pk_bf16(v0[0], v0[1]); w.y = cvt_pk_bf16(v0[2], v0[3]); w.z = cvt_pk_bf16(v1[0], v1[1]); w.w = cvt_pk_bf16(v1[2], v1[3]);
                    *(u32x4*)(xb + off + bj * HALF) = w;
                    sq += ((v0[0] * v0[0] + v0[1] * v0[1]) + (v0[2] * v0[2] + v0[3] * v0[3])) + ((v1[0] * v1[0] + v1[1] * v1[1]) + (v1[2] * v1[2] + v1[3] * v1[3])); }
                sq += __shfl_xor(sq, 16); sq += __shfl_xor(sq, 32);
                if (fq == 0) ss[(size_t)row * 16 + u.pn * 4 + wc] = sq; }
    }
};
template <class Epi, class Sched, bool ALIGN_EPI = false, bool SP2 = false>
__device__ __forceinline__ void gemm_phase(PG8_LAS unsigned char* lds, const Gemm g, const Sched& S, const Epi& E) {
    int tid_ = threadIdx.x; asm volatile("" : "+v"(tid_));
    const int tid = tid_, wid = __builtin_amdgcn_readfirstlane(tid >> 6), lane = tid & 63, wr = wid >> 2, wc = wid & 3, fr = lane & 15, fq = lane >> 4;
    const int K = g.K, nt = K / BK;
    unsigned voffA[2], voffB[2];
#pragma unroll
    for (int i = 0; i < 2; ++i) { int R, C; stage_rc(tid * 16 + i * 8192, R, C); const int Rb = Epi::PERM ? ((R & ~31) + perm32(R & 31)) : R;
        voffA[i] = (unsigned)(R * K + C) * 2u; voffB[i] = (unsigned)(Rb * K + C) * 2u; }
    const size_t kstep = (size_t)(BK * 2);
    const size_t hstep = (size_t)HALF * K * 2;
    const size_t tstep = 2 * hstep;
    const unsigned ldsw = (unsigned)wid * 1024u;
    const int aoff = lds_byte(wr * 64 + fr, fq * 8), boff = lds_byte(wc * 32 + fr, fq * 8);
#define PG8_SA(b, h) (((b) * 2 + (h)) * HTB)
#define PG8_SB(b, h) ((4 + (b) * 2 + (h)) * HTB)
#define PG8_STAGE(bufoff, gbase, voff) do { _Pragma("unroll") for (int _i = 0; _i < 2; ++_i) \
        __builtin_amdgcn_global_load_lds((const unsigned*)((const char*)(gbase) + (voff)[_i]), (PG8_LAS unsigned*)(lds + (bufoff) + ldsw + _i * 8192), 16, 0, 0); } while (0)
#define PG8_LDA(dst, b, h) do { _Pragma("unroll") for (int m = 0; m < 4; ++m) _Pragma("unroll") for (int k = 0; k < 2; ++k) dst[m][k] = *(const PG8_LAS bf16x8*)(lds + PG8_SA(b, h) + aoff + m * 2048 + k * 1024); } while (0)
#define PG8_LDB(dst, b, h) do { _Pragma("unroll") for (int n = 0; n < 2; ++n) _Pragma("unroll") for (int k = 0; k < 2; ++k) dst[n][k] = *(const PG8_LAS bf16x8*)(lds + PG8_SB(b, h) + boff + n * 2048 + k * 1024); } while (0)
#define PG8_MMA(ai, bj, At, Bt) do { __builtin_amdgcn_s_setprio(1); _Pragma("unroll") for (int m = 0; m < 4; ++m) _Pragma("unroll") for (int n = 0; n < 2; ++n) _Pragma("unroll") for (int k = 0; k < 2; ++k) \
        acc[ai][bj][m][n] = __builtin_amdgcn_mfma_f32_16x16x32_bf16(Bt[n][k], At[m][k], acc[ai][bj][m][n], 0, 0, 0); __builtin_amdgcn_s_setprio(0); } while (0)
#define PG8_WAIT_V(n) asm volatile("s_waitcnt vmcnt(" #n ")" ::: "memory")
#define PG8_WAIT_L(n) asm volatile("s_waitcnt lgkmcnt(" #n ")" ::: "memory")
#define PG8_BAR __builtin_amdgcn_s_barrier()
#define PG8_SCHED __builtin_amdgcn_sched_barrier(0)
    Unit cur, nxt; int ui = 0, rs_pm = -1;
    if (!S.next(0, cur)) return;
    f32x4 acc[2][2][4][2];
#pragma unroll
    for (int a = 0; a < 2; ++a)
#pragma unroll
        for (int b = 0; b < 2; ++b)
#pragma unroll
            for (int m = 0; m < 4; ++m)
#pragma unroll
                for (int n = 0; n < 2; ++n) acc[a][b][m][n] = (f32x4){0.f, 0.f, 0.f, 0.f};
    bf16x8 At[4][2], B0[2][2], B1[2][2];
    const char* cA = (const char*)g.A + (size_t)cur.pm * tstep; const char* cB = (const char*)g.Bt + (size_t)cur.pn * tstep;
    S.a_ready(cur);
    if constexpr (SP2) {
        PG8_STAGE(PG8_SB(0, 0), cB, voffB); PG8_STAGE(PG8_SB(0, 1), cB + hstep, voffB); PG8_STAGE(PG8_SA(0, 0), cA, voffA); PG8_STAGE(PG8_SA(0, 1), cA + hstep, voffA);
        if (wr == 1) PG8_BAR;
        PG8_WAIT_V(2); PG8_BAR;
        PG8_STAGE(PG8_SB(1, 0), cB + kstep, voffB); PG8_STAGE(PG8_SA(1, 0), cA + kstep, voffA); PG8_STAGE(PG8_SB(1, 1), cB + hstep + kstep, voffB);
        PG8_WAIT_V(6); PG8_BAR;
    } else {
        PG8_STAGE(PG8_SB(0, 0), cB, voffB); PG8_STAGE(PG8_SA(0, 0), cA, voffA); PG8_STAGE(PG8_SB(0, 1), cB + hstep, voffB); PG8_STAGE(PG8_SA(0, 1), cA + hstep, voffA);
        if (wr == 1) PG8_BAR;
        PG8_WAIT_V(4); PG8_BAR;
        PG8_STAGE(PG8_SB(1, 0), cB + kstep, voffB); PG8_STAGE(PG8_SA(1, 0), cA + kstep, voffA); PG8_STAGE(PG8_SB(1, 1), cB + hstep + kstep, voffB);
        PG8_WAIT_V(6); PG8_BAR;
    }
    for (;;) {
        const bool has_next = S.next(ui + 1, nxt);
        const char* nA = has_next ? (const char*)g.A + (size_t)nxt.pm * tstep : cA; const char* nB = has_next ? (const char*)g.Bt + (size_t)nxt.pn * tstep : cB;
        for (int t = 0; t < nt; t += 2) {
            const bool last = (t == nt - 2);
            const char* a1 = cA + (size_t)(t + 1) * kstep;
            const char* a2 = last ? nA : cA + (size_t)(t + 2) * kstep; const char* b2 = last ? nB : cB + (size_t)(t + 2) * kstep;
            const char* a3 = a2 + kstep; const char* b3 = b2 + kstep;
            if (last && has_next) S.a_ready(nxt);
            if constexpr (SP2) {
            PG8_LDB(B0, 0, 0); PG8_LDB(B1, 0, 1); PG8_SCHED; PG8_LDA(At, 0, 0); PG8_STAGE(PG8_SA(1, 1), a1 + hstep, voffA);
            PG8_WAIT_V(8); PG8_WAIT_L(0); PG8_BAR; PG8_MMA(0, 0, At, B0); PG8_MMA(0, 1, At, B1); PG8_BAR; PG8_SCHED;
            PG8_LDA(At, 0, 1); PG8_STAGE(PG8_SB(0, 0), b2, voffB); PG8_STAGE(PG8_SB(0, 1), b2 + hstep, voffB); PG8_STAGE(PG8_SA(0, 0), a2, voffA);
            PG8_WAIT_V(8); PG8_WAIT_L(0); PG8_BAR; PG8_MMA(1, 0, At, B0); PG8_MMA(1, 1, At, B1); PG8_BAR; PG8_SCHED;
            PG8_LDB(B0, 1, 0); PG8_LDB(B1, 1, 1); PG8_SCHED; PG8_LDA(At, 1, 0); PG8_STAGE(PG8_SA(0, 1), a2 + hstep, voffA);
            PG8_WAIT_V(8); PG8_WAIT_L(0); PG8_BAR; PG8_MMA(0, 0, At, B0); PG8_MMA(0, 1, At, B1); PG8_BAR; PG8_SCHED;
            PG8_LDA(At, 1, 1); PG8_STAGE(PG8_SB(1, 0), b3, voffB); PG8_STAGE(PG8_SB(1, 1), b3 + hstep, voffB); PG8_STAGE(PG8_SA(1, 0), a3, voffA);
            PG8_WAIT_V(8); PG8_WAIT_L(0); PG8_BAR; PG8_MMA(1, 0, At, B0); PG8_MMA(1, 1, At, B1); PG8_BAR; PG8_SCHED;
            } else {
            PG8_LDB(B0, 0, 0); PG8_SCHED; PG8_LDA(At, 0, 0); PG8_STAGE(PG8_SA(1, 1), a1 + hstep, voffA);
            PG8_WAIT_L(8); PG8_BAR; PG8_WAIT_L(0); PG8_MMA(0, 0, At, B0); PG8_BAR; PG8_SCHED;
            PG8_LDB(B1, 0, 1); PG8_STAGE(PG8_SB(0, 0), b2, voffB);
            PG8_BAR; PG8_WAIT_L(0); PG8_MMA(0, 1, At, B1); PG8_BAR;
            PG8_LDA(At, 0, 1); PG8_STAGE(PG8_SA(0, 0), a2, voffA);
            PG8_BAR; PG8_WAIT_L(0); PG8_MMA(1, 0, At, B0); PG8_BAR; PG8_SCHED;
            PG8_STAGE(PG8_SB(0, 1), b2 + hstep, voffB);
            PG8_WAIT_V(6); PG8_BAR; PG8_MMA(1, 1, At, B1); PG8_BAR;
            PG8_LDB(B0, 1, 0); PG8_SCHED; PG8_LDA(At, 1, 0); PG8_STAGE(PG8_SA(0, 1), a2 + hstep, voffA);
            PG8_WAIT_L(8); PG8_BAR; PG8_WAIT_L(0); PG8_MMA(0, 0, At, B0); PG8_BAR; PG8_SCHED;
            PG8_LDB(B1, 1, 1); PG8_STAGE(PG8_SB(1, 0), b3, voffB);
            PG8_BAR; PG8_WAIT_L(0); PG8_MMA(0, 1, At, B1); PG8_BAR;
            PG8_LDA(At, 1, 1); PG8_STAGE(PG8_SA(1, 0), a3, voffA);
            PG8_BAR; PG8_WAIT_L(0); PG8_MMA(1, 0, At, B0); PG8_BAR; PG8_SCHED;
            PG8_STAGE(PG8_SB(1, 1), b3 + hstep, voffB);
            PG8_WAIT_V(6); PG8_BAR; PG8_MMA(1, 1, At, B1); PG8_BAR;
            }
        }
        if constexpr (ALIGN_EPI) { if (wr == 0) PG8_BAR; }
        if constexpr (Epi::RSTD) {
            static_assert(ALIGN_EPI, "the rstd table's barrier needs both half-workgroups at the same point");
            if (cur.pm != rs_pm) { if (tid < 256) ((PG8_LAS float*)(lds + STAGE_BYTES))[tid] = row_rstd(E.ss, cur.pm * BM + tid);
                asm volatile("s_waitcnt lgkmcnt(0)" ::: "memory"); PG8_BAR; asm volatile("" ::: "memory"); rs_pm = cur.pm; } }
        if constexpr (!Epi::AFTER_DRAIN) { E(acc, cur, wr, wc, fr, fq); S.done(cur); }
        if (!has_next) break;
#pragma unroll
        for (int a = 0; a < 2; ++a)
#pragma unroll
            for (int b = 0; b < 2; ++b)
#pragma unroll
                for (int m = 0; m < 4; ++m)
#pragma unroll
                    for (int n = 0; n < 2; ++n) acc[a][b][m][n] = (f32x4){0.f, 0.f, 0.f, 0.f};
        cur = nxt; cA = nA; cB = nB; ++ui;
        if constexpr (ALIGN_EPI) { if (wr == 1) PG8_BAR; }
    }
    PG8_WAIT_V(0);
    if constexpr (!ALIGN_EPI) { if (wr == 0) PG8_BAR; }
    PG8_BAR;
    if constexpr (Epi::AFTER_DRAIN) { E.fused(acc, cur, wr, wc, fr, fq, lds, wid, lane); S.done(cur); }
#undef PG8_SA
#undef PG8_SB
#undef PG8_STAGE
#undef PG8_LDA
#undef PG8_LDB
#undef PG8_MMA
#undef PG8_WAIT_V
#undef PG8_WAIT_L
#undef PG8_BAR
#undef PG8_SCHED
}
}
#define GAS __attribute__((address_space(1)))
#define LAS __attribute__((address_space(3)))
typedef unsigned short bf16;
typedef unsigned v4u __attribute__((ext_vector_type(4)));
typedef float f32x4 __attribute__((ext_vector_type(4)));
typedef short bf16x8 __attribute__((ext_vector_type(8)));
typedef GAS unsigned gu32;
typedef GAS unsigned long long gu64;
#define RLX_AGENT __ATOMIC_RELAXED, __HIP_MEMORY_SCOPE_AGENT
#define LDS_WAIT() asm volatile("s_waitcnt lgkmcnt(0)" ::: "memory")
#define VM_WAIT() asm volatile("s_waitcnt vmcnt(0)" ::: "memory")
__device__ __forceinline__ unsigned long long rt() { return __builtin_amdgcn_s_memrealtime(); }
__device__ __forceinline__ unsigned f2bf(float f) { unsigned u = __builtin_bit_cast(unsigned, f); return (u + 0x7fffu + ((u >> 16) & 1u)) >> 16; }
__device__ __forceinline__ unsigned pk2(float lo, float hi) { return pg8::cvt_pk_bf16(lo, hi); }

#define XB_TMO      128
#define XB_XCNT(j)  (256  + 64 * (j))
#define XB_XSUB(j)  (1280 + 64 * (j))
#define XB_XGEN(j)  (2304 + 64 * (j))
#define XB_TOP      3328
#define XB_TOPGEN   3392
#define XCD_BAR_WORDS 3456
#define XB_SPIN_CAP (1u << 18)

__device__ __forceinline__ unsigned xb_ld(unsigned* p)              { return __hip_atomic_load(p, __ATOMIC_RELAXED, __HIP_MEMORY_SCOPE_AGENT); }
__device__ __forceinline__ unsigned xb_add(unsigned* p, unsigned v) { return __hip_atomic_fetch_add(p, v, __ATOMIC_RELAXED, __HIP_MEMORY_SCOPE_AGENT); }
__device__ __forceinline__ unsigned xb_xcc_id() { return (unsigned)__builtin_amdgcn_s_getreg((3 << 11) | 20) & 0xFu; }
#define XB_SPIN(cond, bar) do { unsigned _sp = 0; while (cond) { __builtin_amdgcn_s_sleep(1); \
    if ((++_sp & 255u) == 0u) { if (xb_ld(&(bar)[XB_TMO])) break; if (_sp > XB_SPIN_CAP) { atomicAdd(&(bar)[XB_TMO], 1u); break; } } } } while (0)

struct XcdBarrier {
    unsigned* bar; unsigned x;
    volatile LAS unsigned* st;
};

__device__ __forceinline__ XcdBarrier xcd_barrier_post(unsigned* bar, volatile LAS unsigned* st) {
    XcdBarrier b; b.bar = bar; b.x = xb_xcc_id(); b.st = st;
    if (threadIdx.x == 0) (void)xb_add(&bar[XB_XCNT(b.x)], 1u);
    return b;
}
__device__ __forceinline__ void xcd_barrier_complete(unsigned* bar, unsigned x, unsigned& nloc, unsigned& nx) {
    const unsigned G = gridDim.x * gridDim.y * gridDim.z;
    unsigned sum, cnt, mine, sp = 0u;
    for (;;) {
        sum = 0u; cnt = 0u; mine = 0u;
#pragma unroll
        for (unsigned j = 0; j < 16; ++j) { const unsigned c = xb_ld(&bar[XB_XCNT(j)]); sum += c; cnt += (c > 0u) ? 1u : 0u; mine = (j == x) ? c : mine; }
        if (sum == G) break;
        __builtin_amdgcn_s_sleep(1);
        if ((++sp & 255u) == 0u) { if (xb_ld(&bar[XB_TMO])) break; if (sp > XB_SPIN_CAP) { atomicAdd(&bar[XB_TMO], 1u); break; } }
    }
    nloc = mine > 0u ? mine : 1u; nx = cnt > 0u ? cnt : 1u;
}

__device__ __forceinline__ void xcd_barrier(const XcdBarrier& b) {
    asm volatile("s_waitcnt vmcnt(0)" ::: "memory");
    __syncthreads();
    if (threadIdx.x == 0) {
        unsigned* bar = b.bar;
        __builtin_amdgcn_s_waitcnt(0);
        unsigned nloc = b.st[0], nx = b.st[1];
        if (nloc == 0u) { xcd_barrier_complete(bar, b.x, nloc, nx); b.st[0] = nloc; b.st[1] = nx; }
        const unsigned old = xb_add(&bar[XB_XSUB(b.x)], 1u);
        const unsigned gen = old / nloc;
        if (old + 1u == (gen + 1u) * nloc) {
            __builtin_amdgcn_fence(__ATOMIC_RELEASE, "agent");
            asm volatile("s_waitcnt vmcnt(0)" ::: "memory");
            const unsigned og = xb_add(&bar[XB_TOP], 1u);
            const unsigned tg = og / nx;
            if (og + 1u == (tg + 1u) * nx) xb_add(&bar[XB_TOPGEN], 1u);
            else XB_SPIN(xb_ld(&bar[XB_TOPGEN]) == tg, bar);
            __builtin_amdgcn_fence(__ATOMIC_ACQUIRE, "agent");
            xb_add(&bar[XB_XGEN(b.x)], 1u);
            asm volatile("s_waitcnt vmcnt(0)" ::: "memory");
        } else {
            XB_SPIN(xb_ld(&bar[XB_XGEN(b.x)]) == gen, bar);
            __builtin_amdgcn_fence(__ATOMIC_ACQUIRE, "agent");
            asm volatile("s_waitcnt vmcnt(0)" ::: "memory");
        }
    }
    __syncthreads();
}
constexpr int NWAVES = 8;
constexpr int NL = 2, NB = 16, NT = 2048, D = 1024, DFF = 2816, M = NB * NT;
constexpr int DIN = 3344, NP = 3584;
constexpr int PC_POOL = 0, PC_HG = 256, PC_RW = 1280, PC_RWX = 2048, PC_GL = 2304;
constexpr int N_PHASES = 18;
constexpr size_t MiB = 1u << 20;
constexpr size_t WS_CTL = 0, CTL_ZERO_BYTES = 64 * 1024;
constexpr size_t WS_SS = 1 * MiB;
constexpr size_t WS_W = 4 * MiB, W_LAYER = 42 * MiB;
constexpr size_t WO_1IN = 0, WO_1OUT = 11 * MiB, WO_IN = 16 * MiB + MiB / 2, WO_OUT = 23 * MiB + MiB / 2, WO_2IN = 25 * MiB + MiB / 2, WO_2OUT = 36 * MiB + MiB / 2;
constexpr size_t WS_XB = 88 * MiB;
constexpr size_t WS_Y = 152 * MiB;
constexpr size_t WS_HP = 216 * MiB;
constexpr size_t WS_LORA = 3 * MiB;
constexpr size_t WS_POOLW = WS_LORA + 256 * 1024;
constexpr size_t WS_END = 440 * MiB;
static_assert(WO_2OUT + (size_t)D * DFF * 2 == W_LAYER && WS_W + NL * W_LAYER == WS_XB && WS_HP + (size_t)M * NP * 2 == WS_END, "d_ws map");
constexpr int CW_BAR = 1024;
constexpr int RING_OFF = 0, RING_BYTES = 131072;
constexpr int LDS_BYTES = 163840;
constexpr int LDSCTL_OFF = LDS_BYTES - 1024, MISC_OFF = LDSCTL_OFF + 320;
struct Args { const float* in[30]; float* out; unsigned char* ws; int ph_lo, ph_hi; };
template <int I> __device__ __forceinline__ const float* kin() {
    const auto ka = __builtin_amdgcn_kernarg_segment_ptr(); const GAS float* p;
    asm volatile("s_load_dwordx2 %0, %1, %2\n\ts_waitcnt lgkmcnt(0)" : "=s"(p) : "s"(ka), "n"(I * 8) : "memory");
    return (const float*)p;
}
__device__ __forceinline__ int otid() { int t = threadIdx.x; asm volatile("" : "+v"(t)); return t; }
struct Frame {
    LAS unsigned char* lds; volatile LAS unsigned* MISC; gu32* ctl;
    int G, vcu;
    float* out; unsigned char* ws;
    bf16 *XB, *Y, *HP; float* SS;
};
__device__ __forceinline__ float wave_sum(float v) {
#pragma unroll
    for (int o = 1; o < 64; o <<= 1) v += __shfl_xor(v, o);
    return v;
}
__device__ __forceinline__ float bf_lo(unsigned u) { return __builtin_bit_cast(float, u << 16); }
__device__ __forceinline__ float bf_hi(unsigned u) { return __builtin_bit_cast(float, u & 0xffff0000u); }
__device__ __forceinline__ f32x4 ld_bf4(const bf16* p) { const uint2 u = *(const uint2*)p; return (f32x4){bf_lo(u.x), bf_hi(u.x), bf_lo(u.y), bf_hi(u.y)}; }
__device__ __forceinline__ void st_bf4(bf16* p, f32x4 v) { uint2 u; u.x = pk2(v[0], v[1]); u.y = pk2(v[2], v[3]); *(uint2*)p = u; }
using pg8::silu_f;
typedef unsigned u32x2 __attribute__((ext_vector_type(2)));
__device__ __forceinline__ float sigmoid_f(float x) { return __builtin_amdgcn_rcpf(1.0f + __expf(-x)); }
__device__ __forceinline__ float tanh_f(float x) { return 1.0f - 2.0f * __builtin_amdgcn_rcpf(__expf(2.0f * x) + 1.0f); }
template <int CTRL> __device__ __forceinline__ float dpp_f(float x) { return __builtin_bit_cast(float, __builtin_amdgcn_update_dpp(0, __builtin_bit_cast(int, x), CTRL, 0xF, 0xF, true)); }
__device__ __forceinline__ float red8(float x) { x += dpp_f<0xB1>(x); x += dpp_f<0x4E>(x); x += dpp_f<0x141>(x); return x; }
__device__ __forceinline__ float red16(float x) { x = red8(x); x += dpp_f<0x140>(x); return x; }

__device__ __forceinline__ void tr_item(const float* W, int ldw, int sc, const float* gain, const float* w2, bf16* WT, int K, int n0, int k0, LAS float* scr, int lane) {
    if (sc >= 0) {
        const float* src = W + (size_t)(k0 + (lane >> 4)) * ldw + sc + 4 * (lane & 15);
        f32x4 v[16];
#pragma unroll
        for (int i = 0; i < 16; ++i) v[i] = *(const f32x4*)(src + (size_t)(4 * i) * ldw);
#pragma unroll
        for (int i = 0; i < 16; ++i) { if (gain) v[i] = v[i] * gain[k0 + 4 * i + (lane >> 4)]; *(LAS f32x4*)(scr + (4 * i + (lane >> 4)) * 68 + 4 * (lane & 15)) = v[i]; }
    } else {
        const int c = -1 - sc + lane;
        float wv[16];
#pragma unroll
        for (int i = 0; i < 16; ++i) wv[i] = w2[i * 256 + c];
#pragma unroll 4
        for (int kk = 0; kk < 64; ++kk) { const float* wr_ = W + (size_t)(k0 + kk) * ldw + 3328; float v = 0.f;
#pragma unroll
            for (int j = 0; j < 16; ++j) v += wr_[j] * wv[j];
            scr[kk * 68 + lane] = v * gain[k0 + kk]; }
    }
    LDS_WAIT(); asm volatile("" ::: "memory");
#pragma unroll
    for (int k8 = 0; k8 < 8; ++k8) { const LAS float* s = scr + (8 * k8) * 68 + lane;
        v4u o; o.x = pk2(s[0 * 68], s[1 * 68]); o.y = pk2(s[2 * 68], s[3 * 68]); o.z = pk2(s[4 * 68], s[5 * 68]); o.w = pk2(s[6 * 68], s[7 * 68]);
        *(GAS v4u*)(WT + (size_t)(n0 + lane) * K + k0 + 8 * k8) = o; }
    LDS_WAIT(); asm volatile("" ::: "memory");
}
__device__ __forceinline__ int win_src_col(int n) {
    if (n < PC_HG) return n;
    if (n < PC_RW) { const int m = n - PC_HG, h = m >> 8, w = m & 255; return 256 + (w >> 6) * 256 + h * 64 + (w & 63); }
    if (n < PC_RWX) { const int m = n - PC_RW, h = m / 192, w = m % 192; return 1280 + (w >> 6) * 256 + h * 64 + (w & 63); }
    if (n < PC_GL) return n;
    { const int m = n - PC_GL, h = m / 320, w = m % 320, part = w >> 6, j = w & 63; if (part < 4) return 2304 + part * 256 + h * 64 + j; return -1 - (h * 64 + j); }
}
__device__ __forceinline__ void convert_weights(Frame& F, const Args& A, int l0, int l1, int gw, int NGW) {
    const int tid = otid(), lane = tid & 63, wave = __builtin_amdgcn_readfirstlane(tid >> 6);
    LAS float* scr = (LAS float*)(F.lds + RING_OFF + wave * 17408);
    constexpr int I_FIN = (D / 64) * (2 * DFF / 64), I_FOUT = (DFF / 64) * (D / 64), I_IN = (D / 64) * (NP / 64), I_OUT = (D / 64) * (D / 64);
    constexpr int I_LAYER = 2 * I_FIN + 2 * I_FOUT + I_IN + I_OUT;
    for (int it = l0 * I_LAYER + gw; it < l1 * I_LAYER; it += NGW) {
        const int l = it / I_LAYER; int r = it % I_LAYER;
        bf16* wl = (bf16*)(F.ws + WS_W + (size_t)l * W_LAYER);
        if (r < 2 * I_FIN) {
            const int which = r / I_FIN; r %= I_FIN; const int nblk = 2 * DFF / 64, kb = r / nblk, nb = r % nblk, n0 = 64 * nb, pn = n0 >> 8, w = n0 & 255;
            const int sc = (w < 128) ? 128 * pn + w : DFF + 128 * pn + (w - 128);
            tr_item((which ? kin<27>() : kin<2>()) + (size_t)l * D * 2 * DFF, 2 * DFF, sc, (which ? kin<26>() : kin<1>()) + l * D, nullptr, (bf16*)((char*)wl + (which ? WO_2IN : WO_1IN)), D, n0, 64 * kb, scr, lane);
            continue; }
        r -= 2 * I_FIN;
        if (r < 2 * I_FOUT) {
            const int which = r / I_FOUT; r %= I_FOUT; const int nblk = D / 64, kb = r / nblk, nb = r % nblk;
            tr_item((which ? kin<28>() : kin<3>()) + (size_t)l * DFF * D, D, 64 * nb, nullptr, nullptr, (bf16*)((char*)wl + (which ? WO_2OUT : WO_1OUT)), DFF, 64 * nb, 64 * kb, scr, lane);
            continue; }
        r -= 2 * I_FOUT;
        if (r < I_IN) {
            const int nblk = NP / 64, kb = r / nblk, nb = r % nblk;
            tr_item(kin<5>() + (size_t)l * D * DIN, DIN, win_src_col(64 * nb), kin<4>() + l * D, kin<23>() + l * 16 * 256, (bf16*)((char*)wl + WO_IN), D, 64 * nb, 64 * kb, scr, lane);
            continue; }
        r -= I_IN;
        { const int nblk = D / 64, kb = r / nblk, nb = r % nblk;
          tr_item(kin<6>() + (size_t)l * D * D, D, 64 * nb, nullptr, nullptr, (bf16*)((char*)wl + WO_OUT), D, 64 * nb, 64 * kb, scr, lane); }
    }
}
__device__ __forceinline__ void p0_prologue(Frame& F, const Args& A) {
    const int tid = otid(), lane = tid & 63, wave = __builtin_amdgcn_readfirstlane(tid >> 6);
    const int gw = F.vcu * NWAVES + wave, NGW = F.G * NWAVES;
    convert_weights(F, A, 0, 1, gw, NGW);
    for (int e = blockIdx.x * (NWAVES * 64) + tid; e < NL * 4 * 16384; e += F.G * NWAVES * 64) { const int lh = e >> 14, r = e & 16383, l = lh >> 2, h = lh & 3; float v;
        if (r < 4096) v = kin<14>()[((size_t)l * 64 + (r & 63)) * 256 + h * 64 + (r >> 6)];
        else if (r < 8192) v = kin<16>()[((size_t)l * 64 + (r & 63)) * 256 + h * 64 + ((r - 4096) >> 6)];
        else v = kin<17>()[((size_t)l * 128 + ((r - 8192) & 127)) * 256 + h * 64 + ((r - 8192) >> 7)];
        ((bf16*)(F.ws + WS_LORA))[e] = (bf16)f2bf(v); }
    for (int e = blockIdx.x * (NWAVES * 64) + tid; e < NL * 16384; e += F.G * NWAVES * 64) { const int l = e >> 14, r = e & 16383, g = r >> 12, d = (r >> 6) & 63, cc = r & 63;
        ((bf16*)(F.ws + WS_POOLW))[e] = (bf16)f2bf(kin<7>()[(size_t)l * 16384 + (g * 64 + cc) * 64 + d]); }
    const float* x = kin<0>();
    for (int m = gw; m < M; m += NGW) {
        const GAS f32x4* xr = (const GAS f32x4*)(x + (size_t)m * D) + lane; f32x4 v[4]; float s = 0.f;
#pragma unroll
        for (int j = 0; j < 4; ++j) { v[j] = xr[64 * j]; s += (v[j][0] * v[j][0] + v[j][1] * v[j][1]) + (v[j][2] * v[j][2] + v[j][3] * v[j][3]); }
        s = wave_sum(s);
        GAS unsigned long long* o8 = (GAS unsigned long long*)(F.XB + (size_t)m * D) + lane;
#pragma unroll
        for (int j = 0; j < 4; ++j) o8[64 * j] = (unsigned long long)pk2(v[j][0], v[j][1]) | ((unsigned long long)pk2(v[j][2], v[j][3]) << 32);
        if (lane < 16) F.SS[(size_t)m * 16 + lane] = (lane == 0) ? s : 0.f;
    }
}
typedef short s16x4 __attribute__((ext_vector_type(4)));
__device__ __forceinline__ f32x4 mfma16(bf16x8 a, bf16x8 b, f32x4 c) { return __builtin_amdgcn_mfma_f32_16x16x32_bf16(a, b, c, 0, 0, 0); }
__device__ __forceinline__ bf16x8 frag_rm(const LAS bf16* img, int pitch, int i0, int k0, int lane) { return *(const LAS bf16x8*)(img + (i0 + (lane & 15)) * pitch + k0 + 8 * (lane >> 4)); }
__device__ __forceinline__ bf16x8 frag_tr(const LAS bf16* img, int pitch, int i0, int k0, int lane) {
    LAS s16x4* a = (LAS s16x4*)(img + (k0 + 8 * (lane >> 4) + ((lane & 15) >> 2)) * pitch + i0 + 4 * (lane & 3));
    const s16x4 v0 = __builtin_amdgcn_ds_read_tr16_b64_v4i16(a), v1 = __builtin_amdgcn_ds_read_tr16_b64_v4i16((LAS s16x4*)((LAS bf16*)a + 4 * pitch));
    return (bf16x8){v0[0], v0[1], v0[2], v0[3], v1[0], v1[1], v1[2], v1[3]};
}
__device__ __forceinline__ float clamp80(float x) { return fminf(fmaxf(x, -80.f), 80.f); }
__device__ __forceinline__ void st_bf8(LAS bf16* p, const float (&v)[8]) { v4u w; w.x = pk2(v[0], v[1]); w.y = pk2(v[2], v[3]); w.z = pk2(v[4], v[5]); w.w = pk2(v[6], v[7]); *(LAS v4u*)p = w; }
__device__ __forceinline__ void ld_bf8g(const bf16* p, float (&v)[8]) { const v4u u = *(const v4u*)p; v[0] = bf_lo(u.x); v[1] = bf_hi(u.x); v[2] = bf_lo(u.y); v[3] = bf_hi(u.y); v[4] = bf_lo(u.z); v[5] = bf_hi(u.z); v[6] = bf_lo(u.w); v[7] = bf_hi(u.w); }
__device__ __forceinline__ void cvt_bf8(const v4u u, float (&v)[8]) { v[0] = bf_lo(u.x); v[1] = bf_hi(u.x); v[2] = bf_lo(u.y); v[3] = bf_hi(u.y); v[4] = bf_lo(u.z); v[5] = bf_hi(u.z); v[6] = bf_lo(u.w); v[7] = bf_hi(u.w); }
__device__ __forceinline__ u32x2 pk4(f32x4 v) { u32x2 w; w.x = pk2(v[0], v[1]); w.y = pk2(v[2], v[3]); return w; }

constexpr int CP = 72, CPF = 68;
constexpr int IMGB = 64 * CP * 2, ARRB = 64 * CPF * 4;
constexpr int G_Q = 0, G_K = IMGB, G_V = 2 * IMGB, G_PS = 3 * IMGB, G_ZT = 4 * IMGB, G_G = 5 * IMGB, G_TOT = G_G + ARRB, G_O = G_TOT + 8 * 64 * 4, G_END = G_O + ARRB;
static_assert(G_END <= RING_BYTES, "chunked GLA LDS map");
__device__ __forceinline__ void cumsum64(LAS float* G, LAS float* TOT, int wave, int lane) {
    float c[8]; float run = 0.f;
#pragma unroll
    for (int i = 0; i < 8; ++i) { run += G[(8 * wave + i) * CPF + lane]; c[i] = run; }
    TOT[wave * 64 + lane] = run;
    __syncthreads();
    float off = 0.f;
#pragma unroll
    for (int q = 0; q < 7; ++q) off += (q < wave) ? TOT[q * 64 + lane] : 0.f;
#pragma unroll
    for (int i = 0; i < 8; ++i) G[(8 * wave + i) * CPF + lane] = c[i] + off;
    __syncthreads();
}
template <int MIX> __device__ __forceinline__ void glalike_chunk_item(Frame& F, int l, int b, int h) {
    LAS bf16* iQ = (LAS bf16*)(F.lds + G_Q); LAS bf16* iK = (LAS bf16*)(F.lds + G_K); LAS bf16* iV = (LAS bf16*)(F.lds + G_V); LAS bf16* iPS = (LAS bf16*)(F.lds + G_PS); LAS bf16* iZT = (LAS bf16*)(F.lds + G_ZT);
    LAS float* fG = (LAS float*)(F.lds + G_G); LAS float* fTOT = (LAS float*)(F.lds + G_TOT); LAS float* fO = (LAS float*)(F.lds + G_O);
    const int tid = otid(), lane = tid & 63, wave = __builtin_amdgcn_readfirstlane(tid >> 6), fr = lane & 15, fq = lane >> 4;
    const int t = tid >> 3, j8 = tid & 7, ch = h * 64 + 8 * j8;
    const int pc = (MIX == 0) ? PC_HG + h * 256 : PC_GL + h * 320;
    float cst0[8], cst1[8];
    if (MIX == 0) {
#pragma unroll
        for (int i = 0; i < 8; ++i) { cst0[i] = (l == 0) ? 0.f : __builtin_amdgcn_rcpf(1.0f + __expf(kin<10>()[ch + i] - kin<10>()[256 + ch + i])); cst1[i] = 0.f; }
    } else {
#pragma unroll
        for (int i = 0; i < 8; ++i) { cst0[i] = kin<24>()[l * 256 + ch + i]; cst1[i] = kin<25>()[l * 256 + ch + i]; }
    }
    const int kt = wave >> 1, vt0 = 2 * (wave & 1);
    f32x4 Z[2] = {{0.f, 0.f, 0.f, 0.f}, {0.f, 0.f, 0.f, 0.f}};
    const bf16* prow = F.HP + ((size_t)b * NT + t) * NP + pc + 8 * j8;
    v4u rq = *(const v4u*)prow, r1 = *(const v4u*)(prow + 64), rv = *(const v4u*)(prow + 128), r3 = *(const v4u*)(prow + 192), r4 = (MIX == 2) ? *(const v4u*)(prow + 256) : rq;
    for (int c = 0; c < NT / 64; ++c) {
        float xq[8], x1[8], xv[8], gg[8], qx[8], kx[8];
        cvt_bf8(rq, xq); cvt_bf8(r1, x1); cvt_bf8(r3, gg);
        {
            float lg[8];
            if (MIX == 0) {
#pragma unroll
                for (int i = 0; i < 8; ++i) { const float f = cst0[i] + (1.0f - cst0[i]) * sigmoid_f(x1[i]); lg[i] = 0.6931471806f * __builtin_amdgcn_logf(fmaxf(f, 1e-30f)); kx[i] = 1.0f - f; qx[i] = silu_f(xq[i]) * 0.125f; }
            } else {
                float ga[8]; cvt_bf8(r4, ga);
#pragma unroll
                for (int i = 0; i < 8; ++i) { const float x = ga[i] + cst0[i]; lg[i] = (fminf(x, 0.f) - 0.6931471806f * __builtin_amdgcn_logf(1.0f + __expf(-fabsf(x)))) * 0.0625f; kx[i] = x1[i]; qx[i] = xq[i] * 0.125f; }
            }
            *(LAS f32x4*)(fG + t * CPF + 8 * j8) = (f32x4){lg[0], lg[1], lg[2], lg[3]}; *(LAS f32x4*)(fG + t * CPF + 8 * j8 + 4) = (f32x4){lg[4], lg[5], lg[6], lg[7]};
            *(LAS v4u*)(iV + t * CP + 8 * j8) = rv;
        }
        if (c + 1 < NT / 64) { const bf16* pn = prow + (size_t)(c + 1) * 64 * NP;
            rq = *(const v4u*)pn; r1 = *(const v4u*)(pn + 64); rv = *(const v4u*)(pn + 128); r3 = *(const v4u*)(pn + 192); if (MIX == 2) r4 = *(const v4u*)(pn + 256); }
        __syncthreads();
        cumsum64(fG, fTOT, wave, lane);
        {
            const f32x4 b0 = *(const LAS f32x4*)(fG + t * CPF + 8 * j8), b1 = *(const LAS f32x4*)(fG + t * CPF + 8 * j8 + 4);
            const f32x4 p0 = *(const LAS f32x4*)(fG + 31 * CPF + 8 * j8), p1 = *(const LAS f32x4*)(fG + 31 * CPF + 8 * j8 + 4);
            float qt[8], ktv[8];
#pragma unroll
            for (int i = 0; i < 4; ++i) { qt[i] = qx[i] * __expf(clamp80(b0[i] - p0[i])); qt[4 + i] = qx[4 + i] * __expf(clamp80(b1[i] - p1[i]));
                ktv[i] = kx[i] * __expf(clamp80(p0[i] - b0[i])); ktv[4 + i] = kx[4 + i] * __expf(clamp80(p1[i] - b1[i])); }
            st_bf8(iQ + t * CP + 8 * j8, qt); st_bf8(iK + t * CP + 8 * j8, ktv);
            const f32x4 er = *(const LAS f32x4*)(fG + 31 * CPF + 16 * kt + 4 * fq);
#pragma unroll
            for (int i = 0; i < 2; ++i) { f32x4 zs;
#pragma unroll
                for (int rg = 0; rg < 4; ++rg) zs[rg] = Z[i][rg] * __expf(er[rg]);
                *(LAS u32x2*)(iZT + (16 * (vt0 + i) + fr) * CP + 16 * kt + 4 * fq) = pk4(zs); }
        }
        __syncthreads();
        {
            const int st = kt;
#pragma unroll
            for (int i = 0; i < 2; ++i) { const int tt = vt0 + i; f32x4 acc = {0.f, 0.f, 0.f, 0.f};
                if (st <= tt) {
#pragma unroll
                    for (int ks = 0; ks < 2; ++ks) acc = mfma16(frag_rm(iK, CP, 16 * st, 32 * ks, lane), frag_rm(iQ, CP, 16 * tt, 32 * ks, lane), acc);
#pragma unroll
                    for (int rg = 0; rg < 4; ++rg) if (16 * st + 4 * fq + rg > 16 * tt + fr) acc[rg] = 0.f;
                }
                *(LAS u32x2*)(iPS + (16 * tt + fr) * CP + 16 * st + 4 * fq) = pk4(acc); }
        }
        __syncthreads();
        {
            const int vt = kt;
#pragma unroll
            for (int i = 0; i < 2; ++i) { const int tt = vt0 + i; f32x4 acc = {0.f, 0.f, 0.f, 0.f};
#pragma unroll
                for (int ks = 0; ks < 2; ++ks) { acc = mfma16(frag_tr(iV, CP, 16 * vt, 32 * ks, lane), frag_rm(iPS, CP, 16 * tt, 32 * ks, lane), acc);
                    acc = mfma16(frag_rm(iZT, CP, 16 * vt, 32 * ks, lane), frag_rm(iQ, CP, 16 * tt, 32 * ks, lane), acc); }
                *(LAS f32x4*)(fO + (16 * tt + fr) * CPF + 16 * vt + 4 * fq) = acc; }
            const f32x4 bc = *(const LAS f32x4*)(fG + 63 * CPF + 16 * kt + 4 * fq), er = *(const LAS f32x4*)(fG + 31 * CPF + 16 * kt + 4 * fq);
#pragma unroll
            for (int i = 0; i < 2; ++i) { f32x4 acc = {0.f, 0.f, 0.f, 0.f};
#pragma unroll
                for (int ks = 0; ks < 2; ++ks) acc = mfma16(frag_tr(iK, CP, 16 * kt, 32 * ks, lane), frag_tr(iV, CP, 16 * (vt0 + i), 32 * ks, lane), acc);
#pragma unroll
                for (int rg = 0; rg < 4; ++rg) Z[i][rg] = __expf(bc[rg]) * Z[i][rg] + __expf(bc[rg] - er[rg]) * acc[rg]; }
        }
        __syncthreads();
        {
            const size_t row = (size_t)b * NT + c * 64 + t;
            const f32x4 o0 = *(const LAS f32x4*)(fO + t * CPF + 8 * j8), o1 = *(const LAS f32x4*)(fO + t * CPF + 8 * j8 + 4);
            float y[8];
            if (MIX == 0) {
#pragma unroll
                for (int i = 0; i < 4; ++i) { y[i] = o0[i]; y[4 + i] = o1[i]; }
                v4u w; w.x = pk2(y[0], y[1]); w.y = pk2(y[2], y[3]); w.z = pk2(y[4], y[5]); w.w = pk2(y[6], y[7]); *(v4u*)(F.Y + row * D + 256 + ch) = w;
            } else {
                const float ms = red8(((o0[0] * o0[0] + o0[1] * o0[1]) + (o0[2] * o0[2] + o0[3] * o0[3])) + ((o1[0] * o1[0] + o1[1] * o1[1]) + (o1[2] * o1[2] + o1[3] * o1[3]))) * (1.0f / 64.0f);
                const float rs = __builtin_amdgcn_rsqf(ms + 1e-6f);
#pragma unroll
                for (int i = 0; i < 4; ++i) { y[i] = o0[i] * rs * cst1[i] * silu_f(gg[i]); y[4 + i] = o1[i] * rs * cst1[4 + i] * silu_f(gg[4 + i]); }
                v4u w; w.x = pk2(y[0], y[1]); w.y = pk2(y[2], y[3]); w.z = pk2(y[4], y[5]); w.w = pk2(y[6], y[7]); *(v4u*)(F.Y + row * D + 768 + ch) = w;
            }
        }
    }
    __syncthreads();
}
constexpr int SLOT = 64 * CP * 2;
constexpr int R_FA = 12 * SLOT, R_FB = R_FA + ARRB, R_TOT = R_FB + ARRB, R_END = R_TOT + 8 * 64 * 4;
static_assert(R_END <= LDSCTL_OFF, "chunked RWKV LDS map");
constexpr int R_TAB = R_END;
static_assert(R_TAB + 2304 * 4 <= LDSCTL_OFF, "RWKV constant table");
__device__ __forceinline__ void rwkv_fill_tab(Frame& F, int l, int tid) {
    LAS float* tab = (LAS float*)(F.lds + R_TAB);
    for (int i = tid; i < 1024; i += NWAVES * 64) tab[i] = kin<12>()[l * 1024 + i];
    if (tid < 256) { tab[1024 + tid] = kin<13>()[l * 256 + tid]; tab[1280 + tid] = kin<15>()[l * 256 + tid]; tab[1536 + tid] = kin<18>()[l * 256 + tid]; tab[1792 + tid] = kin<19>()[l * 256 + tid]; tab[2048 + tid] = kin<20>()[l * 256 + tid]; }
    __syncthreads();
}
constexpr size_t XS_UNIT = 32768, XS2_UNIT = 16384, XS2_OFF = 64 * MiB;
struct RwPre { v4u c[7], p[7]; float pm; };
__device__ __forceinline__ void rw_prefetch(Frame& F, int b, int h, int c, int tid, RwPre& q) {
    const int t = tid >> 3, j8 = tid & 7, tpos = c * 64 + t; const bf16* cur = F.HP + ((size_t)b * NT + tpos) * NP; const bf16* prv = (tpos > 0) ? cur - NP : cur; q.pm = (tpos > 0) ? 1.0f : 0.0f;
    const int off[7] = {PC_RW + h * 192 + 8 * j8, PC_RW + h * 192 + 64 + 8 * j8, PC_RW + h * 192 + 128 + 8 * j8, PC_RWX + 8 * j8, PC_RWX + 64 + 8 * j8, PC_RWX + 128 + 16 * j8, PC_RWX + 136 + 16 * j8};
#pragma unroll
    for (int i = 0; i < 7; ++i) { q.c[i] = *(const v4u*)(cur + off[i]); q.p[i] = *(const v4u*)(prv + off[i]); }
}
__device__ __forceinline__ void rwkv_chunk_unit(Frame& F, int l, int b, int h, int c, RwPre& pre, bool has_next, int nb, int nh, int nc) {
    const int tid = otid(), lane = tid & 63, wave = __builtin_amdgcn_readfirstlane(tid >> 6), fr = lane & 15, fq = lane >> 4;
    const int t = tid >> 3, j8 = tid & 7, ch = h * 64 + 8 * j8;
    const int kt = wave >> 1, vt0 = 2 * (wave & 1);
#define SL(i) ((LAS bf16*)(F.lds + (i) * SLOT))
    LAS bf16* iXW = SL(0); LAS bf16* iXA = SL(1); LAS bf16* iXG = SL(2); LAS bf16* iW2 = SL(4); LAS bf16* iA2 = SL(5); LAS bf16* iG2 = SL(6);
    LAS bf16* iAp = SL(0); LAS bf16* iRp = SL(1); LAS bf16* iBt = SL(2); LAS bf16* iKt = SL(3); LAS bf16* iV = SL(8);
    LAS bf16* iAab = SL(4); LAS bf16* iAak = SL(5); LAS bf16* iArb = SL(6); LAS bf16* iArk = SL(7);
    LAS bf16* iT = SL(9); LAS bf16* iX1 = SL(10); LAS bf16* iM = SL(11); LAS bf16* iWh = SL(3); LAS bf16* iUh = SL(5);
    LAS float* fC = (LAS float*)(F.lds + R_FA); LAS float* fB = (LAS float*)(F.lds + R_FB); LAS float* fTOT = (LAS float*)(F.lds + R_TOT);
    const int unit = (b * 4 + h) * (NT / 64) + c;
    unsigned char* xs = (unsigned char*)F.out + (size_t)unit * XS_UNIT; unsigned char* xs2 = (unsigned char*)F.out + XS2_OFF + (size_t)unit * XS2_UNIT;
    float xr[8], xk[8], xv[8];
    {
        const float pm = pre.pm;
        const LAS float* mu = (const LAS float*)(F.lds + R_TAB);
        const bf16* lw = (const bf16*)(F.ws + WS_LORA) + (size_t)(l * 4 + h) * 16384;
        const int wn = tid >> 3, wk8 = (tid & 7) * 8, wk16 = (tid & 7) * 16;
        const v4u wq0 = *(const v4u*)(lw + wn * 64 + wk8), wq1 = *(const v4u*)(lw + 4096 + wn * 64 + wk8), wq2 = *(const v4u*)(lw + 8192 + wn * 128 + wk16), wq3 = *(const v4u*)(lw + 8192 + wn * 128 + wk16 + 8);
        float a_[8], p_[8], o_[8];
#define SHIFT(dst, idx, muoff) do { cvt_bf8(pre.c[idx], a_); cvt_bf8(pre.p[idx], p_); const f32x4 m0_ = *(const LAS f32x4*)(mu + (muoff)), m1_ = *(const LAS f32x4*)(mu + (muoff) + 4); \
            _Pragma("unroll") for (int i = 0; i < 4; ++i) { dst[i] = a_[i] + (p_[i] * pm - a_[i]) * m0_[i]; dst[4 + i] = a_[4 + i] + (p_[4 + i] * pm - a_[4 + i]) * m1_[i]; } } while (0)
        SHIFT(xr, 0, ch); SHIFT(xk, 1, 256 + ch); SHIFT(xv, 2, 512 + ch);
        st_bf8(iV + t * CP + 8 * j8, xv);
        SHIFT(o_, 3, 768 + 8 * j8);
#pragma unroll
        for (int i = 0; i < 8; ++i) o_[i] = tanh_f(o_[i]);
        st_bf8(iXW + t * CP + 8 * j8, o_);
        SHIFT(o_, 4, 832 + 8 * j8); st_bf8(iXA + t * CP + 8 * j8, o_);
        SHIFT(o_, 5, 896 + 16 * j8);
#pragma unroll
        for (int i = 0; i < 8; ++i) o_[i] = sigmoid_f(o_[i]);
        st_bf8(iXG + t * 136 + 16 * j8, o_);
        SHIFT(o_, 6, 904 + 16 * j8);
#pragma unroll
        for (int i = 0; i < 8; ++i) o_[i] = sigmoid_f(o_[i]);
        st_bf8(iXG + t * 136 + 16 * j8 + 8, o_);
#undef SHIFT
        *(LAS v4u*)(iW2 + wn * CP + wk8) = wq0; *(LAS v4u*)(iA2 + wn * CP + wk8) = wq1; *(LAS v4u*)(iG2 + wn * 136 + wk16) = wq2; *(LAS v4u*)(iG2 + wn * 136 + wk16 + 8) = wq3;
        if (has_next) rw_prefetch(F, nb, nh, nc, tid, pre);
    }
    __syncthreads();
    {
        const int nt = kt;
        const f32x4 w0v = *(const LAS f32x4*)((const LAS float*)(F.lds + R_TAB) + 1024 + h * 64 + 16 * nt + 4 * fq), a0v = *(const LAS f32x4*)((const LAS float*)(F.lds + R_TAB) + 1280 + h * 64 + 16 * nt + 4 * fq);
#pragma unroll
        for (int i = 0; i < 2; ++i) { const int tt = vt0 + i; f32x4 cw = {0.f, 0.f, 0.f, 0.f}, ca = cw, cg = cw;
#pragma unroll
            for (int ks = 0; ks < 2; ++ks) { cw = mfma16(frag_rm(iW2, CP, 16 * nt, 32 * ks, lane), frag_rm(iXW, CP, 16 * tt, 32 * ks, lane), cw);
                ca = mfma16(frag_rm(iA2, CP, 16 * nt, 32 * ks, lane), frag_rm(iXA, CP, 16 * tt, 32 * ks, lane), ca); }
#pragma unroll
            for (int ks = 0; ks < 4; ++ks) cg = mfma16(frag_rm(iG2, 136, 16 * nt, 32 * ks, lane), frag_rm(iXG, 136, 16 * tt, 32 * ks, lane), cg);
            f32x4 lwv, av;
#pragma unroll
            for (int rg = 0; rg < 4; ++rg) { lwv[rg] = -0.6065306597f * sigmoid_f(w0v[rg] + cw[rg]); av[rg] = sigmoid_f(a0v[rg] + ca[rg]); }
            *(LAS f32x4*)(fC + (16 * tt + fr) * CPF + 16 * nt + 4 * fq) = lwv; *(LAS f32x4*)(fB + (16 * tt + fr) * CPF + 16 * nt + 4 * fq) = av;
            *(u32x2*)((bf16*)xs2 + (16 * tt + fr) * 64 + 16 * nt + 4 * fq) = pk4(cg); }
    }
    __syncthreads();
    float lw8[8], a8[8];
    { const f32x4 u0 = *(const LAS f32x4*)(fC + t * CPF + 8 * j8), u1 = *(const LAS f32x4*)(fC + t * CPF + 8 * j8 + 4), v0 = *(const LAS f32x4*)(fB + t * CPF + 8 * j8), v1 = *(const LAS f32x4*)(fB + t * CPF + 8 * j8 + 4);
#pragma unroll
      for (int i = 0; i < 4; ++i) { lw8[i] = u0[i]; lw8[4 + i] = u1[i]; a8[i] = v0[i]; a8[4 + i] = v1[i]; } }
    __syncthreads();
    cumsum64(fC, fTOT, wave, lane);
    {
        const f32x4 c0 = *(const LAS f32x4*)(fC + t * CPF + 8 * j8), c1 = *(const LAS f32x4*)(fC + t * CPF + 8 * j8 + 4), p0 = *(const LAS f32x4*)(fC + 31 * CPF + 8 * j8), p1 = *(const LAS f32x4*)(fC + 31 * CPF + 8 * j8 + 4);
        float kk[8], n2 = 0.f, bon = 0.f, kx[8], ckk[8], cka[8], crk[8];
        { const LAS float* q18 = (const LAS float*)(F.lds + R_TAB) + 1536 + ch; const LAS float* q19 = q18 + 256; const LAS float* q20 = q18 + 512;
          const f32x4 a0_ = *(const LAS f32x4*)q18, a1_ = *(const LAS f32x4*)(q18 + 4), b0_ = *(const LAS f32x4*)q19, b1_ = *(const LAS f32x4*)(q19 + 4), c0_ = *(const LAS f32x4*)q20, c1_ = *(const LAS f32x4*)(q20 + 4);
#pragma unroll
          for (int i = 0; i < 4; ++i) { ckk[i] = a0_[i]; ckk[4 + i] = a1_[i]; cka[i] = b0_[i]; cka[4 + i] = b1_[i]; crk[i] = c0_[i]; crk[4 + i] = c1_[i]; } }
#pragma unroll
        for (int i = 0; i < 8; ++i) { kk[i] = xk[i] * ckk[i]; n2 += kk[i] * kk[i]; kx[i] = xk[i] * (1.0f + (a8[i] - 1.0f) * cka[i]); bon += xr[i] * kx[i] * crk[i]; }
        n2 = red8(n2); bon = red8(bon); const float inv = 1.0f / fmaxf(sqrtf(n2), 1e-12f);
        float o_[8];
#pragma unroll
        for (int i = 0; i < 8; ++i) o_[i] = bon * xv[i];
        { v4u w; w.x = pk2(o_[0], o_[1]); w.y = pk2(o_[2], o_[3]); w.z = pk2(o_[4], o_[5]); w.w = pk2(o_[6], o_[7]); *(v4u*)((bf16*)xs2 + 4096 + t * 64 + 8 * j8) = w; }
        float cc[8], rho[8];
#pragma unroll
        for (int i = 0; i < 4; ++i) { cc[i] = c0[i]; cc[4 + i] = c1[i]; rho[i] = p0[i]; rho[4 + i] = p1[i]; }
#pragma unroll
        for (int i = 0; i < 8; ++i) o_[i] = kk[i] * inv * __expf(clamp80(cc[i] - lw8[i] - rho[i]));
        st_bf8(iAp + t * CP + 8 * j8, o_);
#pragma unroll
        for (int i = 0; i < 8; ++i) o_[i] = xr[i] * __expf(clamp80(cc[i] - rho[i]));
        st_bf8(iRp + t * CP + 8 * j8, o_);
#pragma unroll
        for (int i = 0; i < 8; ++i) { const float ek = __expf(clamp80(rho[i] - cc[i])); o_[i] = kk[i] * inv * a8[i] * ek; kx[i] *= ek; }
        st_bf8(iBt + t * CP + 8 * j8, o_); st_bf8(iKt + t * CP + 8 * j8, kx);
        for (int i = tid; i < SLOT / 16; i += NWAVES * 64) { *(LAS v4u*)((LAS unsigned char*)iT + i * 16) = (v4u){0u, 0u, 0u, 0u}; *(LAS v4u*)((LAS unsigned char*)iM + i * 16) = (v4u){0u, 0u, 0u, 0u}; }
    }
    __syncthreads();
    {
        const int it = kt;
#pragma unroll
        for (int i = 0; i < 2; ++i) { const int tt = vt0 + i; f32x4 ab = {0.f, 0.f, 0.f, 0.f}, ak = ab, rb = ab, rk = ab;
            if (it <= tt) {
#pragma unroll
                for (int ks = 0; ks < 2; ++ks) { const bf16x8 fb = frag_rm(iBt, CP, 16 * it, 32 * ks, lane), fk = frag_rm(iKt, CP, 16 * it, 32 * ks, lane), fa = frag_rm(iAp, CP, 16 * tt, 32 * ks, lane), fr_ = frag_rm(iRp, CP, 16 * tt, 32 * ks, lane);
                    ab = mfma16(fb, fa, ab); ak = mfma16(fk, fa, ak); rb = mfma16(fb, fr_, rb); rk = mfma16(fk, fr_, rk); }
#pragma unroll
                for (int rg = 0; rg < 4; ++rg) { const int ii = 16 * it + 4 * fq + rg, tq = 16 * tt + fr; if (ii >= tq) { ab[rg] = 0.f; ak[rg] = 0.f; } if (ii > tq) { rb[rg] = 0.f; rk[rg] = 0.f; } }
            }
            const int o = (16 * tt + fr) * CP + 16 * it + 4 * fq;
            *(LAS u32x2*)(iAab + o) = pk4(ab); *(LAS u32x2*)(iAak + o) = pk4(ak); *(LAS u32x2*)(iArb + o) = pk4(rb); *(LAS u32x2*)(iArk + o) = pk4(rk);
            if (it == tt) {
#pragma unroll
                for (int rg = 0; rg < 4; ++rg) fB[(16 * it + 4 * fq + rg) * CPF + 16 * tt + fr] = ab[rg]; } }
    }
    __syncthreads();
    f32x4 accO[2], accQ[2];
    {
        const int vt = kt;
#pragma unroll
        for (int i = 0; i < 2; ++i) { const int tt = vt0 + i; f32x4 x1 = {0.f, 0.f, 0.f, 0.f}; accO[i] = x1; accQ[i] = x1;
#pragma unroll
            for (int ks = 0; ks < 2; ++ks) { const bf16x8 fv = frag_tr(iV, CP, 16 * vt, 32 * ks, lane);
                x1 = mfma16(fv, frag_rm(iAak, CP, 16 * tt, 32 * ks, lane), x1); accO[i] = mfma16(fv, frag_rm(iArk, CP, 16 * tt, 32 * ks, lane), accO[i]);
                accQ[i] = mfma16(frag_tr(iKt, CP, 16 * kt, 32 * ks, lane), frag_tr(iV, CP, 16 * (vt0 + i), 32 * ks, lane), accQ[i]); }
            *(LAS u32x2*)(iX1 + (16 * tt + fr) * CP + 16 * vt + 4 * fq) = pk4(x1); }
        if (wave == 0) {
            const int blk = lane >> 4, j = lane & 15; float x[16];
#pragma unroll
            for (int tq = 0; tq < 16; ++tq) x[tq] = (tq == j) ? 1.0f : 0.0f;
            const LAS float* at = fB + (16 * blk) * CPF + 16 * blk;
#pragma unroll
            for (int i = 0; i < 15; ++i) {
                const f32x4 r0 = *(const LAS f32x4*)(at + i * CPF), r1 = *(const LAS f32x4*)(at + i * CPF + 4), r2 = *(const LAS f32x4*)(at + i * CPF + 8), r3 = *(const LAS f32x4*)(at + i * CPF + 12);
                const float ar[16] = {r0[0], r0[1], r0[2], r0[3], r1[0], r1[1], r1[2], r1[3], r2[0], r2[1], r2[2], r2[3], r3[0], r3[1], r3[2], r3[3]};
#pragma unroll
                for (int tq = i + 1; tq < 16; ++tq) x[tq] -= ar[tq] * x[i]; }
#pragma unroll
            for (int tq = 0; tq < 16; ++tq) iT[(16 * blk + tq) * CP + 16 * blk + j] = (bf16)f2bf(x[tq]);
        }
    }
    __syncthreads();
    if (wave < 2) {
        const int o = 32 * wave; f32x4 m = {0.f, 0.f, 0.f, 0.f};
        m = mfma16(frag_tr(iT, CP, o, o, lane), frag_rm(iAab, CP, o + 16, o, lane), m);
        *(LAS u32x2*)(iM + (o + 16 + fr) * CP + o + 4 * fq) = pk4(m); }
    __syncthreads();
    if (wave < 2) {
        const int o = 32 * wave; f32x4 m = {0.f, 0.f, 0.f, 0.f};
        m = mfma16(frag_tr(iM, CP, o, o, lane), frag_rm(iT, CP, o + 16, o, lane), m);
        *(LAS u32x2*)(iT + (o + 16 + fr) * CP + o + 4 * fq) = pk4(-m); }
    __syncthreads();
    if (wave < 4) {
        const int jt = wave >> 1, tt = wave & 1; f32x4 m = {0.f, 0.f, 0.f, 0.f};
        m = mfma16(frag_tr(iT, CP, 16 * jt, 0, lane), frag_rm(iAab, CP, 32 + 16 * tt, 0, lane), m);
        *(LAS u32x2*)(iM + (16 * tt + fr) * CP + 16 * jt + 4 * fq) = pk4(m); }
    __syncthreads();
    if (wave < 4) {
        const int jt = wave >> 1, tt = wave & 1; f32x4 m = {0.f, 0.f, 0.f, 0.f};
        m = mfma16(frag_tr(iM, CP, 16 * jt, 0, lane), frag_rm(iT, CP, 32 + 16 * tt, 32, lane), m);
        *(LAS u32x2*)(iT + (32 + 16 * tt + fr) * CP + 16 * jt + 4 * fq) = pk4(-m); }
    __syncthreads();
    {
#pragma unroll
        for (int i = 0; i < 2; ++i) { const int tt = vt0 + i; f32x4 w = {0.f, 0.f, 0.f, 0.f}, u = w;
#pragma unroll
            for (int ks = 0; ks < 2; ++ks) { const bf16x8 ft = frag_rm(iT, CP, 16 * tt, 32 * ks, lane);
                w = mfma16(frag_tr(iAp, CP, 16 * kt, 32 * ks, lane), ft, w); u = mfma16(frag_tr(iX1, CP, 16 * kt, 32 * ks, lane), ft, u); }
            *(LAS u32x2*)(iWh + (16 * tt + fr) * CP + 16 * kt + 4 * fq) = pk4(w); *(LAS u32x2*)(iUh + (16 * tt + fr) * CP + 16 * kt + 4 * fq) = pk4(u); }
    }
    __syncthreads();
    {
        const f32x4 rho4 = *(const LAS f32x4*)(fC + 31 * CPF + 16 * kt + 4 * fq), cC4 = *(const LAS f32x4*)(fC + 63 * CPF + 16 * kt + 4 * fq);
        f32x4 dr4, de4;
#pragma unroll
        for (int rg = 0; rg < 4; ++rg) { dr4[rg] = __expf(rho4[rg]); de4[rg] = __expf(cC4[rg] - rho4[rg]); }
#pragma unroll
        for (int i = 0; i < 2; ++i) { const int xt = vt0 + i;
            f32x4 p = {0.f, 0.f, 0.f, 0.f}, q = p, r = p, o = p;
#pragma unroll
            for (int ks = 0; ks < 2; ++ks) { const bf16x8 fw = frag_tr(iWh, CP, 16 * kt, 32 * ks, lane), fbk = frag_tr(iBt, CP, 16 * kt, 32 * ks, lane), fu = frag_tr(iUh, CP, 16 * xt, 32 * ks, lane), fa = frag_rm(iArb, CP, 16 * xt, 32 * ks, lane);
                p = mfma16(fw, frag_tr(iBt, CP, 16 * xt, 32 * ks, lane), p);
                q = mfma16(fbk, fu, q);
                r = mfma16(fw, fa, r);
                o = mfma16(frag_tr(iUh, CP, 16 * kt, 32 * ks, lane), fa, o); }
            const int kp = 16 * xt + fr; const float dep = __expf(fC[63 * CPF + kp] - fC[31 * CPF + kp]);
            f32x4 pv, qv, rv; const u32x2 rb2 = *(const LAS u32x2*)(iRp + (16 * xt + fr) * CP + 16 * kt + 4 * fq);
            const f32x4 rbar = {bf_lo(rb2.x), bf_hi(rb2.x), bf_lo(rb2.y), bf_hi(rb2.y)};
#pragma unroll
            for (int rg = 0; rg < 4; ++rg) { const float dlt = (kp == 16 * kt + 4 * fq + rg) ? 1.0f : 0.0f; pv[rg] = dep * (dlt - p[rg]) * dr4[rg]; qv[rg] = de4[rg] * (accQ[i][rg] - q[rg]); rv[rg] = (rbar[rg] - r[rg]) * dr4[rg]; }
            *(u32x2*)((bf16*)xs + kp * 64 + 16 * kt + 4 * fq) = pk4(pv);
            *(u32x2*)((bf16*)xs + 4096 + (16 * xt + fr) * 64 + 16 * kt + 4 * fq) = pk4(rv);
            *(u32x2*)((bf16*)xs + 8192 + (kt * 4 + xt) * 256 + lane * 4) = pk4(qv);
            *(u32x2*)((bf16*)xs + 12288 + (kt * 4 + xt) * 256 + lane * 4) = pk4(accO[i] - o); }
    }
    __syncthreads();
#undef SL
}
constexpr int Q_P = 0, Q_R = SLOT, Q_ZT = 2 * SLOT, Q_ZL = 3 * SLOT, Q_O = 4 * SLOT, Q_END = Q_O + ARRB;
__device__ __forceinline__ void rwkv_seq_item(Frame& F, int l, int b, int h) {
    const int tid = otid(), lane = tid & 63, wave = __builtin_amdgcn_readfirstlane(tid >> 6), fr = lane & 15, fq = lane >> 4;
    const int t = tid >> 3, j8 = tid & 7, ch = h * 64 + 8 * j8, kt = wave >> 1, vt0 = 2 * (wave & 1);
    LAS bf16* iP = (LAS bf16*)(F.lds + Q_P); LAS bf16* iR = (LAS bf16*)(F.lds + Q_R); LAS bf16* iZT = (LAS bf16*)(F.lds + Q_ZT); LAS bf16* iZL = (LAS bf16*)(F.lds + Q_ZL); LAS float* fO = (LAS float*)(F.lds + Q_O);
    float lnw[8], lnb[8];
#pragma unroll
    for (int i = 0; i < 8; ++i) { lnw[i] = kin<21>()[l * 256 + ch + i]; lnb[i] = kin<22>()[l * 256 + ch + i]; }
    f32x4 Z[2] = {{0.f, 0.f, 0.f, 0.f}, {0.f, 0.f, 0.f, 0.f}};
    const size_t unit0 = (size_t)(b * 4 + h) * (NT / 64);
    const unsigned char* xs = (const unsigned char*)F.out + unit0 * XS_UNIT; const unsigned char* xs2 = (const unsigned char*)F.out + XS2_OFF + unit0 * XS2_UNIT;
    v4u pP = *(const v4u*)(xs + tid * 16), pR = *(const v4u*)(xs + 8192 + tid * 16), pG = *(const v4u*)(xs2 + tid * 16), pE = *(const v4u*)(xs2 + 8192 + tid * 16);
    u32x2 pQ[2], pO[2];
#pragma unroll
    for (int i = 0; i < 2; ++i) { pQ[i] = *(const u32x2*)(xs + 16384 + ((kt * 4 + vt0 + i) * 256 + lane * 4) * 2); pO[i] = *(const u32x2*)(xs + 24576 + ((kt * 4 + vt0 + i) * 256 + lane * 4) * 2); }
    for (int c = 0; c < NT / 64; ++c) {
        *(LAS v4u*)(iP + (tid >> 3) * CP + (tid & 7) * 8) = pP; *(LAS v4u*)(iR + (tid >> 3) * CP + (tid & 7) * 8) = pR;
#pragma unroll
        for (int i = 0; i < 2; ++i) {
            const u32x2 hi = pk4(Z[i]); const f32x4 hf = {bf_lo(hi.x), bf_hi(hi.x), bf_lo(hi.y), bf_hi(hi.y)};
            *(LAS u32x2*)(iZT + (16 * (vt0 + i) + fr) * CP + 16 * kt + 4 * fq) = hi; *(LAS u32x2*)(iZL + (16 * (vt0 + i) + fr) * CP + 16 * kt + 4 * fq) = pk4(Z[i] - hf); }
        f32x4 q0[2], o0[2]; float gv[8], ev[8];
#pragma unroll
        for (int i = 0; i < 2; ++i) { q0[i] = (f32x4){bf_lo(pQ[i].x), bf_hi(pQ[i].x), bf_lo(pQ[i].y), bf_hi(pQ[i].y)}; o0[i] = (f32x4){bf_lo(pO[i].x), bf_hi(pO[i].x), bf_lo(pO[i].y), bf_hi(pO[i].y)}; }
        cvt_bf8(pG, gv); cvt_bf8(pE, ev);
        if (c + 1 < NT / 64) { const unsigned char* xn = xs + (size_t)(c + 1) * XS_UNIT; const unsigned char* xn2 = xs2 + (size_t)(c + 1) * XS2_UNIT;
            pP = *(const v4u*)(xn + tid * 16); pR = *(const v4u*)(xn + 8192 + tid * 16); pG = *(const v4u*)(xn2 + tid * 16); pE = *(const v4u*)(xn2 + 8192 + tid * 16);
#pragma unroll
            for (int i = 0; i < 2; ++i) { pQ[i] = *(const u32x2*)(xn + 16384 + ((kt * 4 + vt0 + i) * 256 + lane * 4) * 2); pO[i] = *(const u32x2*)(xn + 24576 + ((kt * 4 + vt0 + i) * 256 + lane * 4) * 2); } }
        __syncthreads();
#pragma unroll
        for (int i = 0; i < 2; ++i) {
            f32x4 o = o0[i], z = q0[i];
#pragma unroll
            for (int ks = 0; ks < 2; ++ks) { const bf16x8 fR = frag_rm(iR, CP, 16 * (vt0 + i), 32 * ks, lane), fP = frag_rm(iP, CP, 16 * kt, 32 * ks, lane);
                o = mfma16(frag_rm(iZT, CP, 16 * kt, 32 * ks, lane), fR, o); o = mfma16(frag_rm(iZL, CP, 16 * kt, 32 * ks, lane), fR, o);
                z = mfma16(fP, frag_rm(iZT, CP, 16 * (vt0 + i), 32 * ks, lane), z); z = mfma16(fP, frag_rm(iZL, CP, 16 * (vt0 + i), 32 * ks, lane), z); }
            *(LAS f32x4*)(fO + (16 * (vt0 + i) + fr) * CPF + 16 * kt + 4 * fq) = o; Z[i] = z; }
        __syncthreads();
        {
            const f32x4 a0 = *(const LAS f32x4*)(fO + t * CPF + 8 * j8), a1 = *(const LAS f32x4*)(fO + t * CPF + 8 * j8 + 4);
            const float mean = red8(((a0[0] + a0[1]) + (a0[2] + a0[3])) + ((a1[0] + a1[1]) + (a1[2] + a1[3]))) * (1.0f / 64.0f);
            const f32x4 d0 = a0 - mean, d1 = a1 - mean;
            const float var = red8(((d0[0] * d0[0] + d0[1] * d0[1]) + (d0[2] * d0[2] + d0[3] * d0[3])) + ((d1[0] * d1[0] + d1[1] * d1[1]) + (d1[2] * d1[2] + d1[3] * d1[3]))) * (1.0f / 64.0f);
            const float rs = __builtin_amdgcn_rsqf(var + 64e-5f); float y[8];
#pragma unroll
            for (int i = 0; i < 4; ++i) { y[i] = (d0[i] * rs * lnw[i] + lnb[i] + ev[i]) * gv[i]; y[4 + i] = (d1[i] * rs * lnw[4 + i] + lnb[4 + i] + ev[4 + i]) * gv[4 + i]; }
            v4u w; w.x = pk2(y[0], y[1]); w.y = pk2(y[2], y[3]); w.z = pk2(y[4], y[5]); w.w = pk2(y[6], y[7]);
            *(v4u*)(F.Y + ((size_t)b * NT + c * 64 + t) * D + 512 + ch) = w;
        }
    }
    __syncthreads();
}
constexpr int SC = 32;
constexpr int LA_BYTES = SC * 64 * 4;
constexpr int L_XW = 8 * LA_BYTES, L_XA = L_XW + SC * 144, L_XG = L_XA + SC * 144, L_W2T = L_XG + SC * 272, L_A2T = L_W2T + 64 * 144, L_G2T = L_A2T + 64 * 144, L_SCAN_END = L_G2T + 64 * 272;
static_assert(L_SCAN_END <= RING_BYTES, "scan LDS map");

__device__ __forceinline__ void scan_rwkv(const LAS float* W_, const LAS float* KK, const LAS float* KA, const LAS float* KX, const LAS float* R, const LAS float* V, LAS float* O, float (&S)[8], int wave, int lane) {
    const int ks = lane & 7, v = wave * 8 + (lane >> 3);
#pragma unroll 2
    for (int t = 0; t < SC; ++t) {
        const int o8 = t * 64 + ks * 8;
        const f32x4 w0 = *(const LAS f32x4*)(W_ + o8), w1 = *(const LAS f32x4*)(W_ + o8 + 4);
        const f32x4 c0 = *(const LAS f32x4*)(KK + o8), c1 = *(const LAS f32x4*)(KK + o8 + 4);
        const f32x4 e0 = *(const LAS f32x4*)(KA + o8), e1 = *(const LAS f32x4*)(KA + o8 + 4);
        const f32x4 k0 = *(const LAS f32x4*)(KX + o8), k1 = *(const LAS f32x4*)(KX + o8 + 4);
        const f32x4 r0 = *(const LAS f32x4*)(R + o8), r1 = *(const LAS f32x4*)(R + o8 + 4);
        const float vv = V[t * 64 + v];
        float d = 0.f;
#pragma unroll
        for (int j = 0; j < 4; ++j) d += S[j] * c0[j] + S[4 + j] * c1[j];
        d = red8(d);
        float o = 0.f;
#pragma unroll
        for (int j = 0; j < 4; ++j) { S[j] = S[j] * w0[j] + (vv * k0[j] - d * e0[j]); S[4 + j] = S[4 + j] * w1[j] + (vv * k1[j] - d * e1[j]); o += S[j] * r0[j] + S[4 + j] * r1[j]; }
        o = red8(o);
        if (ks == 0) O[t * 64 + v] = o;
    }
}

__device__ __forceinline__ void rwkv_item(Frame& F, const Args& A, int l, int b, int h) {
    LAS float* fW = (LAS float*)(F.lds + 0 * LA_BYTES); LAS float* fKK = (LAS float*)(F.lds + 1 * LA_BYTES); LAS float* fKA = (LAS float*)(F.lds + 2 * LA_BYTES); LAS float* fKX = (LAS float*)(F.lds + 3 * LA_BYTES);
    LAS float* fR = (LAS float*)(F.lds + 4 * LA_BYTES); LAS float* fV = (LAS float*)(F.lds + 5 * LA_BYTES); LAS float* fO = (LAS float*)(F.lds + 6 * LA_BYTES); LAS float* fG = (LAS float*)(F.lds + 7 * LA_BYTES);
    LAS bf16* sXW = (LAS bf16*)(F.lds + L_XW); LAS bf16* sXA = (LAS bf16*)(F.lds + L_XA); LAS bf16* sXG = (LAS bf16*)(F.lds + L_XG);
    LAS bf16* sW2 = (LAS bf16*)(F.lds + L_W2T); LAS bf16* sA2 = (LAS bf16*)(F.lds + L_A2T); LAS bf16* sG2 = (LAS bf16*)(F.lds + L_G2T);
    const int tid = otid(), lane = tid & 63, wave = __builtin_amdgcn_readfirstlane(tid >> 6), t = tid >> 4, j = tid & 15, ch = h * 64 + 4 * j;
    for (int i = tid; i < 64 * 64; i += NWAVES * 64) { const int k = i >> 6, n = i & 63;
        sW2[n * 72 + k] = (bf16)f2bf(kin<14>()[((size_t)l * 64 + k) * 256 + h * 64 + n]); sA2[n * 72 + k] = (bf16)f2bf(kin<16>()[((size_t)l * 64 + k) * 256 + h * 64 + n]); }
    for (int i = tid; i < 128 * 64; i += NWAVES * 64) { const int k = i >> 6, n = i & 63; sG2[n * 136 + k] = (bf16)f2bf(kin<17>()[((size_t)l * 128 + k) * 256 + h * 64 + n]); }
    const float* mu = kin<12>() + l * 1024;
    const f32x4 mu_r = *(const f32x4*)(mu + ch), mu_k = *(const f32x4*)(mu + 256 + ch), mu_v = *(const f32x4*)(mu + 512 + ch);
    const f32x4 mu_w = *(const f32x4*)(mu + 768 + 4 * j), mu_a = *(const f32x4*)(mu + 832 + 4 * j), mu_g0 = *(const f32x4*)(mu + 896 + 8 * j), mu_g1 = *(const f32x4*)(mu + 900 + 8 * j);
    const f32x4 c_kk = *(const f32x4*)(kin<18>() + l * 256 + ch), c_ka = *(const f32x4*)(kin<19>() + l * 256 + ch), c_rk = *(const f32x4*)(kin<20>() + l * 256 + ch);
    const f32x4 c_lw = *(const f32x4*)(kin<21>() + l * 256 + ch), c_lb = *(const f32x4*)(kin<22>() + l * 256 + ch);
    const int mt = wave >> 2, nt = wave & 3, fr = lane & 15, fq = lane >> 4;
    const float w0n = kin<13>()[l * 256 + h * 64 + nt * 16 + fr], a0n = kin<15>()[l * 256 + h * 64 + nt * 16 + fr];
    float S[8];
#pragma unroll
    for (int i = 0; i < 8; ++i) S[i] = 0.f;
    __syncthreads();
    for (int c = 0; c < NT / SC; ++c) {
        const int tpos = c * SC + t; const size_t row = (size_t)b * NT + tpos;
        const bf16* cur = F.HP + row * NP; const bf16* prv = (tpos > 0) ? cur - NP : cur; const float pm = (tpos > 0) ? 1.0f : 0.0f;
        {
            const bf16* ph = cur + PC_RW + h * 192 + 4 * j; const bf16* pp = prv + PC_RW + h * 192 + 4 * j;
            const f32x4 r = ld_bf4(ph), k = ld_bf4(ph + 64), v = ld_bf4(ph + 128);
            const f32x4 rp = ld_bf4(pp) * pm, kp = ld_bf4(pp + 64) * pm, vp = ld_bf4(pp + 128) * pm;
            *(LAS f32x4*)(fR + t * 64 + 4 * j) = r + (rp - r) * mu_r; *(LAS f32x4*)(fKX + t * 64 + 4 * j) = k + (kp - k) * mu_k; *(LAS f32x4*)(fV + t * 64 + 4 * j) = v + (vp - v) * mu_v;
            const f32x4 xw = ld_bf4(cur + PC_RWX + 4 * j), xwp = ld_bf4(prv + PC_RWX + 4 * j) * pm, xa = ld_bf4(cur + PC_RWX + 64 + 4 * j), xap = ld_bf4(prv + PC_RWX + 64 + 4 * j) * pm;
            const f32x4 sw = xw + (xwp - xw) * mu_w, sa = xa + (xap - xa) * mu_a;
            u32x2 u; u.x = pk2(tanh_f(sw[0]), tanh_f(sw[1])); u.y = pk2(tanh_f(sw[2]), tanh_f(sw[3])); *(LAS u32x2*)(sXW + t * 72 + 4 * j) = u;
            u.x = pk2(sa[0], sa[1]); u.y = pk2(sa[2], sa[3]); *(LAS u32x2*)(sXA + t * 72 + 4 * j) = u;
            const f32x4 g0 = ld_bf4(cur + PC_RWX + 128 + 8 * j), g1 = ld_bf4(cur + PC_RWX + 132 + 8 * j), g0p = ld_bf4(prv + PC_RWX + 128 + 8 * j) * pm, g1p = ld_bf4(prv + PC_RWX + 132 + 8 * j) * pm;
            const f32x4 s0 = g0 + (g0p - g0) * mu_g0, s1 = g1 + (g1p - g1) * mu_g1;
            v4u w; w.x = pk2(sigmoid_f(s0[0]), sigmoid_f(s0[1])); w.y = pk2(sigmoid_f(s0[2]), sigmoid_f(s0[3])); w.z = pk2(sigmoid_f(s1[0]), sigmoid_f(s1[1])); w.w = pk2(sigmoid_f(s1[2]), sigmoid_f(s1[3]));
            *(LAS v4u*)(sXG + t * 136 + 8 * j) = w;
        }
        __syncthreads();
        {
            f32x4 cw = {0.f, 0.f, 0.f, 0.f}, ca = cw, cg = cw;
#pragma unroll
            for (int ks = 0; ks < 2; ++ks) {
                cw = mfma16(*(const LAS bf16x8*)(sXW + (mt * 16 + fr) * 72 + ks * 32 + fq * 8), *(const LAS bf16x8*)(sW2 + (nt * 16 + fr) * 72 + ks * 32 + fq * 8), cw);
                ca = mfma16(*(const LAS bf16x8*)(sXA + (mt * 16 + fr) * 72 + ks * 32 + fq * 8), *(const LAS bf16x8*)(sA2 + (nt * 16 + fr) * 72 + ks * 32 + fq * 8), ca); }
#pragma unroll
            for (int ks = 0; ks < 4; ++ks) cg = mfma16(*(const LAS bf16x8*)(sXG + (mt * 16 + fr) * 136 + ks * 32 + fq * 8), *(const LAS bf16x8*)(sG2 + (nt * 16 + fr) * 136 + ks * 32 + fq * 8), cg);
            const int n = nt * 16 + fr;
#pragma unroll
            for (int rg = 0; rg < 4; ++rg) { const int tt = mt * 16 + fq * 4 + rg;
                fW[tt * 64 + n] = __expf(-0.6065306597f * sigmoid_f(w0n + cw[rg]));
                fO[tt * 64 + n] = sigmoid_f(a0n + ca[rg]);
                fG[tt * 64 + n] = cg[rg]; }
        }
        __syncthreads();
        {
            const f32x4 rk = *(const LAS f32x4*)(fKX + t * 64 + 4 * j), a = *(const LAS f32x4*)(fO + t * 64 + 4 * j);
            const f32x4 kr = rk * c_kk; const float n2 = red16((kr[0] * kr[0] + kr[1] * kr[1]) + (kr[2] * kr[2] + kr[3] * kr[3]));
            const float inv = 1.0f / fmaxf(sqrtf(n2), 1e-12f); const f32x4 kk = kr * inv;
            *(LAS f32x4*)(fKK + t * 64 + 4 * j) = kk; *(LAS f32x4*)(fKA + t * 64 + 4 * j) = kk * a;
            f32x4 kx;
#pragma unroll
            for (int i = 0; i < 4; ++i) kx[i] = rk[i] * (1.0f + (a[i] - 1.0f) * c_ka[i]);
            *(LAS f32x4*)(fKX + t * 64 + 4 * j) = kx;
        }
        __syncthreads();
        scan_rwkv(fW, fKK, fKA, fKX, fR, fV, fO, S, wave, lane);
        __syncthreads();
        {
            const f32x4 o = *(const LAS f32x4*)(fO + t * 64 + 4 * j), r = *(const LAS f32x4*)(fR + t * 64 + 4 * j), kx = *(const LAS f32x4*)(fKX + t * 64 + 4 * j);
            const f32x4 v = *(const LAS f32x4*)(fV + t * 64 + 4 * j), g = *(const LAS f32x4*)(fG + t * 64 + 4 * j);
            const float mean = red16((o[0] + o[1]) + (o[2] + o[3])) * (1.0f / 64.0f); const f32x4 dv = o - mean;
            const float var = red16((dv[0] * dv[0] + dv[1] * dv[1]) + (dv[2] * dv[2] + dv[3] * dv[3])) * (1.0f / 64.0f); const float rs = __builtin_amdgcn_rsqf(var + 64e-5f);
            const float bon = red16((r[0] * kx[0] * c_rk[0] + r[1] * kx[1] * c_rk[1]) + (r[2] * kx[2] * c_rk[2] + r[3] * kx[3] * c_rk[3]));
            f32x4 y;
#pragma unroll
            for (int i = 0; i < 4; ++i) y[i] = (dv[i] * rs * c_lw[i] + c_lb[i] + bon * v[i]) * g[i];
            st_bf4(F.Y + row * D + 512 + ch, y);
        }
        __syncthreads();
    }
}

constexpr int L_PX = 0, L_PL = 40960, L_PW = L_PL + 64 * 4 * 72 * 2, L_POOL_END = L_PW + 4 * 64 * 72 * 2;
static_assert(79 * 512 <= L_PL && L_POOL_END <= RING_BYTES, "pool LDS map");
__device__ __forceinline__ void pool_item(Frame& F, const Args& A, int l, int b, int c) {
    LAS bf16* PX = (LAS bf16*)(F.lds + L_PX); LAS bf16* PL = (LAS bf16*)(F.lds + L_PL); LAS bf16* PW = (LAS bf16*)(F.lds + L_PW);
    const int tid = otid(), lane = tid & 63, wave = __builtin_amdgcn_readfirstlane(tid >> 6), t0 = c * 64;
    for (int i = tid; i < 79 * 32; i += NWAVES * 64) { const int r = i >> 5, cc = i & 31, tok = t0 - 15 + r;
        v4u v = {0u, 0u, 0u, 0u}; if (tok >= 0) v = *(const v4u*)(F.HP + ((size_t)b * NT + tok) * NP + PC_POOL + cc * 8);
        *(LAS v4u*)(PX + r * 256 + cc * 8) = v; }
    const bf16* pw = (const bf16*)(F.ws + WS_POOLW) + (size_t)l * 16384;
    for (int i = tid; i < 4 * 64 * 8; i += NWAVES * 64) *(LAS v4u*)(PW + (i >> 3) * 72 + (i & 7) * 8) = *(const v4u*)(pw + i * 8);
    __syncthreads();
    {
        const int t = tid >> 3, g = (tid >> 1) & 3, half = tid & 1, w = 2 << g, col = g * 64 + half * 32;
        const int cntn = (t0 + t + 1 < w) ? (t0 + t + 1) : w; const float rc = 1.0f / (float)cntn;
        f32x4 acc[8];
#pragma unroll
        for (int q = 0; q < 8; ++q) acc[q] = (f32x4){0.f, 0.f, 0.f, 0.f};
        for (int s = 0; s < w; ++s) {
#pragma unroll
            for (int q = 0; q < 4; ++q) { const v4u u = *(const LAS v4u*)(PX + (15 + t - s) * 256 + col + 8 * q);
                acc[2 * q] += (f32x4){bf_lo(u.x), bf_hi(u.x), bf_lo(u.y), bf_hi(u.y)}; acc[2 * q + 1] += (f32x4){bf_lo(u.z), bf_hi(u.z), bf_lo(u.w), bf_hi(u.w)}; } }
#pragma unroll
        for (int q = 0; q < 4; ++q) { const v4u u = *(const LAS v4u*)(PX + (15 + t) * 256 + col + 8 * q);
            const f32x4 p0 = acc[2 * q] * rc - (f32x4){bf_lo(u.x), bf_hi(u.x), bf_lo(u.y), bf_hi(u.y)}, p1 = acc[2 * q + 1] * rc - (f32x4){bf_lo(u.z), bf_hi(u.z), bf_lo(u.w), bf_hi(u.w)};
            v4u o; o.x = pk2(p0[0], p0[1]); o.y = pk2(p0[2], p0[3]); o.z = pk2(p1[0], p1[1]); o.w = pk2(p1[2], p1[3]);
            *(LAS v4u*)(PL + (t * 4 + g) * 72 + half * 32 + 8 * q) = o; }
    }
    __syncthreads();
    {
        const int g = wave & 3, mh = wave >> 2, fr = lane & 15, fq = lane >> 4;
#pragma unroll
        for (int nt = 0; nt < 4; ++nt) { const f32x4 bb = *(const f32x4*)(kin<8>() + l * 256 + g * 64 + 16 * nt + 4 * fq), sc = *(const f32x4*)(kin<9>() + l * 256 + g * 64 + 16 * nt + 4 * fq);
#pragma unroll
            for (int mt = 0; mt < 2; ++mt) { const int tt = 2 * mh + mt; f32x4 acc = {0.f, 0.f, 0.f, 0.f};
#pragma unroll
                for (int ks = 0; ks < 2; ++ks) acc = mfma16(*(const LAS bf16x8*)(PW + (g * 64 + nt * 16 + fr) * 72 + ks * 32 + fq * 8), *(const LAS bf16x8*)(PL + ((16 * tt + fr) * 4 + g) * 72 + ks * 32 + fq * 8), acc);
                *(u32x2*)(F.Y + ((size_t)b * NT + t0 + 16 * tt + fr) * D + g * 64 + 16 * nt + 4 * fq) = pk4((acc + bb) * sc); } }
    }
    __syncthreads();
}
#ifndef RWKV_CHUNKED
#define RWKV_CHUNKED 1
#endif
__device__ __forceinline__ void mixer_phase(Frame& F, const Args& A, int l) {
    constexpr int NBIG = RWKV_CHUNKED ? 2 * NB * 4 : 3 * NB * 4, NRW = RWKV_CHUNKED ? NB * 4 * (NT / 64) : 0, NPOOL = NB * (NT / 64);
    constexpr int RW_SHARE = RWKV_CHUNKED ? 5 * 128 : 0;
    const int nbw = (F.G / 2 < NBIG) ? F.G / 2 : NBIG, g = blockIdx.x;
#if RWKV_CHUNKED
    rwkv_fill_tab(F, l, otid());
#endif
    if (g < nbw) {
        for (int it = g; it < NBIG; it += nbw) { const int mix = it >> 6, b = (it & 63) >> 2, h = it & 3;
            if (mix == 0) glalike_chunk_item<0>(F, l, b, h); else if (mix == 1) glalike_chunk_item<2>(F, l, b, h); else rwkv_item(F, A, l, b, h); }
#if RWKV_CHUNKED
        { RwPre pre; int it = NRW - RW_SHARE + g; if (it < NRW) rw_prefetch(F, it >> 7, (it >> 5) & 3, it & 31, otid(), pre);
          for (; it < NRW; it += nbw) { const int nx = it + nbw; rwkv_chunk_unit(F, l, it >> 7, (it >> 5) & 3, it & 31, pre, nx < NRW, nx >> 7, (nx >> 5) & 3, nx & 31); } }
#endif
    } else {
#if RWKV_CHUNKED
        { RwPre pre; int it = g - nbw; const int st = F.G - nbw, end = NRW - RW_SHARE; if (it < end) rw_prefetch(F, it >> 7, (it >> 5) & 3, it & 31, otid(), pre);
          for (; it < end; it += st) { const int nx = it + st; rwkv_chunk_unit(F, l, it >> 7, (it >> 5) & 3, it & 31, pre, nx < end, nx >> 7, (nx >> 5) & 3, nx & 31); } }
#endif
    }
}
__device__ __forceinline__ void mixer_phase2(Frame& F, const Args& A, int l) {
    const int nsw = RWKV_CHUNKED ? ((F.G / 2 < NB * 4) ? F.G / 2 : NB * 4) : 0, g = blockIdx.x;
    if (g < nsw) {
#if RWKV_CHUNKED
        for (int it = g; it < NB * 4; it += nsw) rwkv_seq_item(F, l, it >> 2, it & 3);
#endif
        return; }
    for (int it = g - nsw; it < NB * (NT / 64); it += F.G - nsw) pool_item(F, A, l, it >> 5, it & 31);
    const int tid = otid(), lane = tid & 63, wave = __builtin_amdgcn_readfirstlane(tid >> 6);
    const int gw = (g - nsw) * NWAVES + wave, NGW = (F.G - nsw) * NWAVES, c = 4 * lane;
    const f32x4 gn = *(const f32x4*)(kin<11>() + l * 256 + c);
    for (int m = gw; m < M; m += NGW) {
        bf16* yp = F.Y + (size_t)m * D + 256 + c; const f32x4 o = ld_bf4(yp);
        const float ms = wave_sum((o[0] * o[0] + o[1] * o[1]) + (o[2] * o[2] + o[3] * o[3])) * (1.0f / 256.0f); const float rs = __builtin_amdgcn_rsqf(ms + 1e-6f);
        const f32x4 hg = ld_bf4(F.HP + (size_t)m * NP + PC_HG + (c >> 6) * 256 + 192 + (c & 63)); f32x4 y;
#pragma unroll
        for (int i = 0; i < 4; ++i) y[i] = o[i] * rs * gn[i] * sigmoid_f(hg[i]);
        st_bf4(yp, y);
    }
    if (l == 0) convert_weights(F, A, 1, NL, (g - nsw) * NWAVES + wave, (F.G - nsw) * NWAVES);
}
__device__ __forceinline__ void final_norm(Frame& F, const Args& A) {
    const int tid = otid(), lane = tid & 63, wave = __builtin_amdgcn_readfirstlane(tid >> 6);
    const int gw = blockIdx.x * NWAVES + wave, NGW = F.G * NWAVES;
    f32x4 g[4];
#pragma unroll
    for (int j = 0; j < 4; ++j) g[j] = *((const f32x4*)kin<29>() + lane + 64 * j);
    for (int m = gw; m < M; m += NGW) { const float rs = pg8::row_rstd(F.SS, m); GAS f32x4* xr = (GAS f32x4*)(F.out + (size_t)m * D) + lane; const bf16* xb = F.XB + (size_t)m * D + 4 * lane;
#pragma unroll
        for (int j = 0; j < 4; ++j) xr[64 * j] = ld_bf4(xb + 256 * j) * rs * g[j]; }
}
#ifndef MK_N_LAUNCHES
#define MK_N_LAUNCHES 1
#endif
__global__ void __launch_bounds__(NWAVES * 64, 2) fwd(Args args) {
    extern __shared__ __attribute__((aligned(16))) unsigned char lds[];
    Frame F;
    F.lds = (LAS unsigned char*)lds; F.MISC = (volatile LAS unsigned*)(F.lds + MISC_OFF);
    F.G = gridDim.x; { const int bx = blockIdx.x; F.vcu = (F.G % 8 == 0) ? (bx % 8) * (F.G / 8) + bx / 8 : bx; }
    F.out = args.out; F.ws = args.ws; F.ctl = (gu32*)(args.ws + WS_CTL);
    F.XB = (bf16*)(args.ws + WS_XB); F.Y = (bf16*)(args.ws + WS_Y); F.HP = (bf16*)(args.ws + WS_HP); F.SS = (float*)(args.ws + WS_SS);
    for (int u = threadIdx.x; u < (LDS_BYTES - LDSCTL_OFF) / 4; u += NWAVES * 64) ((LAS unsigned*)(F.lds + LDSCTL_OFF))[u] = 0u;
    __syncthreads();
    const int lo = args.ph_lo, hi = args.ph_hi;
    XcdBarrier bar; bar.bar = (unsigned*)(F.ctl + CW_BAR); bar.x = 0; bar.st = nullptr;
    if (hi - lo > 1) bar = xcd_barrier_post((unsigned*)(F.ctl + CW_BAR), F.MISC + 8);
#define IN(k) (lo <= (k) && (k) < hi)
#ifndef PROBE_MASK
#define PROBE_MASK 0u
#endif
    unsigned long long pr_acc = 0ull, pr_t0 = (PROBE_MASK != 0u) ? __builtin_amdgcn_s_memrealtime() : 0ull;
#define PSPAN(k) do { if (PROBE_MASK != 0u) { const unsigned long long _t = __builtin_amdgcn_s_memrealtime(); if ((PROBE_MASK >> (k)) & 1u) pr_acc += _t - pr_t0; pr_t0 = _t; } } while (0)
#define SEAM(k) do { if (IN(k) && IN((k) + 1)) xcd_barrier(bar); } while (0)
#ifndef PHMASK
#define PHMASK 0xFFFF
#endif
#define PHEN(k) ((PHMASK >> (k)) & 1)
    if (PHEN(0) && IN(0)) p0_prologue(F, args);
    SEAM(0); PSPAN(0);
    for (int l = 0; l < NL; ++l) {
        const int pb = 1 + 8 * l;
        const unsigned char* wl = args.ws + WS_W + (size_t)l * W_LAYER;
        if (PHEN(1) && IN(pb + 0)) {
            pg8::Gemm g{F.XB, (const bf16*)(wl + WO_1IN), M, 2 * DFF, D}; pg8::StaticOrder S; S.init(M, 2 * DFF, F.G, (int)blockIdx.x);
            pg8::EpiSwiGLU E{F.HP, DFF, F.SS, (const LAS float*)(F.lds + RING_OFF + pg8::STAGE_BYTES)};
            pg8::gemm_phase<pg8::EpiSwiGLU, pg8::StaticOrder, true, true>(F.lds + RING_OFF, g, S, E); }
        SEAM(pb + 0); PSPAN(pb + 0);
        if (PHEN(2) && IN(pb + 1)) {
            pg8::Gemm g{F.HP, (const bf16*)(wl + WO_1OUT), M, D, DFF}; pg8::StaticOrder S; S.init(M, D, F.G, (int)blockIdx.x);
            pg8::EpiResid E{F.XB, F.SS, 0.5f};
            pg8::gemm_phase<pg8::EpiResid, pg8::StaticOrder, true, true>(F.lds + RING_OFF, g, S, E); }
        SEAM(pb + 1); PSPAN(pb + 1);
        if (PHEN(3) && IN(pb + 2)) {
            pg8::Gemm g{F.XB, (const bf16*)(wl + WO_IN), M, NP, D}; pg8::StaticOrder S; S.init(M, NP, F.G, (int)blockIdx.x);
            pg8::EpiScale E{F.HP, NP, F.SS, (const LAS float*)(F.lds + RING_OFF + pg8::STAGE_BYTES)};
            pg8::gemm_phase<pg8::EpiScale, pg8::StaticOrder, true, true>(F.lds + RING_OFF, g, S, E); }
        SEAM(pb + 2); PSPAN(pb + 2);
        if (PHEN(4) && IN(pb + 3)) mixer_phase(F, args, l);
        SEAM(pb + 3); PSPAN(pb + 3);
        if (PHEN(5) && IN(pb + 4)) mixer_phase2(F, args, l);
        SEAM(pb + 4); PSPAN(pb + 4);
        if (PHEN(6) && IN(pb + 5)) {
            pg8::Gemm g{F.Y, (const bf16*)(wl + WO_OUT), M, D, D}; pg8::StaticOrder S; S.init(M, D, F.G, (int)blockIdx.x);
            pg8::EpiResid E{F.XB, F.SS, 1.0f};
            pg8::gemm_phase<pg8::EpiResid, pg8::StaticOrder, true, true>(F.lds + RING_OFF, g, S, E); }
        SEAM(pb + 5); PSPAN(pb + 5);
        if (PHEN(7) && IN(pb + 6)) {
            pg8::Gemm g{F.XB, (const bf16*)(wl + WO_2IN), M, 2 * DFF, D}; pg8::StaticOrder S; S.init(M, 2 * DFF, F.G, (int)blockIdx.x);
            pg8::EpiSwiGLU E{F.HP, DFF, F.SS, (const LAS float*)(F.lds + RING_OFF + pg8::STAGE_BYTES)};
            pg8::gemm_phase<pg8::EpiSwiGLU, pg8::StaticOrder, true, true>(F.lds + RING_OFF, g, S, E); }
        SEAM(pb + 6); PSPAN(pb + 6);
        if (PHEN(8) && IN(pb + 7)) {
            pg8::Gemm g{F.HP, (const bf16*)(wl + WO_2OUT), M, D, DFF}; pg8::StaticOrder S; S.init(M, D, F.G, (int)blockIdx.x);
            pg8::EpiResid E{F.XB, F.SS, 0.5f};
            pg8::gemm_phase<pg8::EpiResid, pg8::StaticOrder, true, true>(F.lds + RING_OFF, g, S, E); }
        SEAM(pb + 7); PSPAN(pb + 7);
    }
    if (PHEN(9) && IN(17)) final_norm(F, args);
    PSPAN(17);
    if (PROBE_MASK != 0u && blockIdx.x == 0) { const unsigned long long _e = __builtin_amdgcn_s_memrealtime(); while (__builtin_amdgcn_s_memrealtime() - _e < pr_acc) __builtin_amdgcn_s_sleep(8); }
#undef IN
#undef SEAM
}

extern "C" void kernel_launch(void* const* d_in, const int* in_sizes, int n_in, void* d_out, int out_size, void* d_ws, size_t ws_size, hipStream_t stream) {
    static int grid = 0;
    if (grid == 0) {
        if (n_in != 30 || in_sizes[0] != M * D || out_size != M * D || ws_size < WS_END) { fprintf(stderr, "kernel_launch: built for 30 inputs, x/out of %d floats, >= %zu bytes of workspace; got n_in %d, in0 %d, out %d, ws %zu; nothing launched\n", M * D, (size_t)WS_END, n_in, n_in > 0 ? in_sizes[0] : -1, out_size, ws_size); grid = -1; return; }
        int dev = 0, cus = 0, per_cu = 0;
        if (hipGetDevice(&dev) != hipSuccess || hipDeviceGetAttribute(&cus, hipDeviceAttributeMultiprocessorCount, dev) != hipSuccess) { fprintf(stderr, "kernel_launch: device query failed\n"); grid = -1; return; }
        if (hipFuncSetAttribute((const void*)fwd, hipFuncAttributeMaxDynamicSharedMemorySize, LDS_BYTES) != hipSuccess) { fprintf(stderr, "kernel_launch: hipFuncSetAttribute failed\n"); grid = -1; return; }
        if (hipOccupancyMaxActiveBlocksPerMultiprocessor(&per_cu, (const void*)fwd, NWAVES * 64, LDS_BYTES) != hipSuccess || per_cu < 1)
            fprintf(stderr, "kernel_launch: note: occupancy query reports %d workgroups per CU\n", per_cu);
        (void)hipGetLastError();
        grid = cus;
    }
    if (grid < 0) return;
    if (hipMemsetAsync((char*)d_ws + WS_CTL, 0, CTL_ZERO_BYTES, stream) != hipSuccess) { fprintf(stderr, "kernel_launch: memset failed\n"); return; }
    Args a{};
    for (int i = 0; i < 30; ++i) a.in[i] = (const float*)d_in[i];
    a.out = (float*)d_out; a.ws = (unsigned char*)d_ws;
    if (MK_N_LAUNCHES == 1) { a.ph_lo = 0; a.ph_hi = N_PHASES; hipLaunchKernelGGL(fwd, dim3(grid), dim3(NWAVES * 64), LDS_BYTES, stream, a); }
    else for (int k = 0; k < N_PHASES; ++k) { a.ph_lo = k; a.ph_hi = k + 1; hipLaunchKernelGGL(fwd, dim3(grid), dim3(NWAVES * 64), LDS_BYTES, stream, a); }
    const hipError_t le = hipPeekAtLastError();
    if (le != hipSuccess) fprintf(stderr, "kernel_launch: launch failed: %s\n", hipGetErrorName(le));
}
```

```cpp
#include <hip/hip_runtime.h>
#include <cstdio>
#include <cstdint>
namespace pg8 {
#define PG8_LAS __attribute__((address_space(3)))
typedef unsigned short bf16_t;
typedef short bf16x8 __attribute__((ext_vector_type(8)));
typedef float f32x4 __attribute__((ext_vector_type(4)));
typedef unsigned u32x4 __attribute__((ext_vector_type(4)));
constexpr int BM = 256, BK = 64, HALF = 128, HTB = HALF * BK * 2  , STAGE_BYTES = 8 * HTB, NXCD = 8, WGM = 8;

__host__ __device__ __forceinline__ int lds_byte(int r, int c) { const int st = (r >> 4) * 2 + (c >> 5), rr = r & 15, cc = c & 31, ob = rr * 64 + cc * 2; return st * 1024 + (ob ^ (((ob >> 9) & 1) << 5)); }
__host__ __device__ __forceinline__ void stage_rc(int b, int& R, int& C) { const int st = b / 1024, sb = b % 1024, swz = sb ^ (((sb >> 9) & 1) << 5); R = (st >> 1) * 16 + swz / 64; C = (st & 1) * 32 + (swz % 64) / 2; }
__host__ __device__ __forceinline__ int perm32(int rho) { const int n = rho >> 4, i = rho & 15; return 8 * (i >> 2) + 4 * n + (i & 3); }

struct Unit { int pm, pn; };
struct Gemm { const bf16_t* A; const bf16_t* Bt; int M, N, K; };

struct StaticOrder {
    int nM, nN, nwg, G, c;
    __host__ __device__ void init(int M, int N, int G_, int c_) { nM = M / BM; nN = N / BM; nwg = nM * nN; G = G_; c = c_; }
    __host__ __device__ bool next(int i, Unit& u) const {
        const long L = (long)i * G + c; if (L >= nwg) return false;
        int wgid = (int)L; { const int q = nwg / NXCD, r = nwg % NXCD, xcd = wgid % NXCD, off = wgid / NXCD; wgid = (xcd < r ? xcd * (q + 1) : r * (q + 1) + (xcd - r) * q) + off; }
        const int nig = WGM * nN, gid = wgid / nig, fm = gid * WGM, gsz = (nM - fm) < WGM ? (nM - fm) : WGM;
        u.pm = fm + ((wgid % nig) % gsz); u.pn = (wgid % nig) / gsz; return true;
    }
    __device__ __forceinline__ void a_ready(const Unit&) const {}
    __device__ __forceinline__ void done(const Unit&) const {}
};
typedef __bf16 bf16x2_cv __attribute__((ext_vector_type(2)));
__device__ __forceinline__ unsigned cvt_pk_bf16(float lo, float hi) { typedef float f32x2_cv __attribute__((ext_vector_type(2))); const f32x2_cv v = {lo, hi}; return __builtin_bit_cast(unsigned, __builtin_convertvector(v, bf16x2_cv)); }
typedef float f32x2 __attribute__((ext_vector_type(2)));
__device__ __forceinline__ float row_rstd(const float* ss, int row) {
    const f32x4* p = (const f32x4*)(ss + (size_t)row * 16);
    const f32x4 a = p[0], b = p[1], c = p[2], d = p[3];
    const float s = (((a[0] + a[1]) + (a[2] + a[3])) + ((b[0] + b[1]) + (b[2] + b[3]))) + (((c[0] + c[1]) + (c[2] + c[3])) + ((d[0] + d[1]) + (d[2] + d[3])));
    return __builtin_amdgcn_rsqf(s * (1.0f / 1024.0f) + 1e-6f);
}
__device__ __forceinline__ float silu_f(float g) { return g * __builtin_amdgcn_rcpf(1.0f + __expf(-g)); }
struct EpiSwiGLU {
    static constexpr bool PERM = true, AFTER_DRAIN = false, RSTD = true;
    bf16_t* H; int ldh; const float* ss; const PG8_LAS float* rstab;
    __device__ __forceinline__ void operator()(const f32x4 (&acc)[2][2][4][2], const Unit& u, int wr, int wc, int fr, int fq) const {
        const int row0 = u.pm * BM + wr * 64 + fr, col0 = u.pn * 128 + wc * 32 + 8 * fq;
#pragma unroll
        for (int ai = 0; ai < 2; ++ai)
#pragma unroll
            for (int m = 0; m < 4; ++m) { const int row = row0 + ai * HALF + m * 16; const float rs = rstab[ai * HALF + wr * 64 + m * 16 + fr];
                const float c1 = rs * -1.44269504f, rs2 = rs * rs; const f32x4 ga = acc[ai][0][m][0], gb = acc[ai][0][m][1], ua = acc[ai][1][m][0], ub = acc[ai][1][m][1];
                float t[8], p[8];
#pragma unroll
                for (int j = 0; j < 4; ++j) { t[j] = ga[j] * c1; t[4 + j] = gb[j] * c1; p[j] = ga[j] * ua[j]; p[4 + j] = gb[j] * ub[j]; }
#pragma unroll
                for (int j = 0; j < 8; ++j) t[j] = __builtin_amdgcn_exp2f(t[j]);
#pragma unroll
                for (int j = 0; j < 8; ++j) { t[j] = 1.0f + t[j]; p[j] *= rs2; }
#pragma unroll
                for (int j = 0; j < 8; ++j) t[j] = __builtin_amdgcn_rcpf(t[j]);
#pragma unroll
                for (int j = 0; j < 8; ++j) p[j] *= t[j];
                u32x4 w; w.x = cvt_pk_bf16(p[0], p[1]); w.y = cvt_pk_bf16(p[2], p[3]); w.z = cvt_pk_bf16(p[4], p[5]); w.w = cvt_pk_bf16(p[6], p[7]);
                *(u32x4*)(H + (size_t)row * ldh + col0) = w; }
    }
};
struct EpiScale {
    static constexpr bool PERM = true, AFTER_DRAIN = false, RSTD = true;
    bf16_t* P; int ldp; const float* ss; const PG8_LAS float* rstab;
    __device__ __forceinline__ void operator()(const f32x4 (&acc)[2][2][4][2], const Unit& u, int wr, int wc, int fr, int fq) const {
        const int row0 = u.pm * BM + wr * 64 + fr, col0 = u.pn * BM + wc * 32 + 8 * fq;
#pragma unroll
        for (int ai = 0; ai < 2; ++ai)
#pragma unroll
            for (int m = 0; m < 4; ++m) { const int row = row0 + ai * HALF + m * 16; const float rs = rstab[ai * HALF + wr * 64 + m * 16 + fr];
#pragma unroll
                for (int bj = 0; bj < 2; ++bj) { const f32x4 v0 = acc[ai][bj][m][0] * rs, v1 = acc[ai][bj][m][1] * rs;
                    u32x4 w; w.x = cvt_pk_bf16(v0[0], v0[1]); w.y = cvt_pk_bf16(v0[2], v0[3]); w.z = cvt_pk_bf16(v1[0], v1[1]); w.w = cvt_pk_bf16(v1[2], v1[3]);
                    *(u32x4*)(P + (size_t)row * ldp + col0 + bj * HALF) = w; } }
    }
};
struct EpiResid {
    static constexpr bool PERM = true, AFTER_DRAIN = false, RSTD = false;
    bf16_t* xb; float* ss; float scale;
    __device__ __forceinline__ void operator()(const f32x4 (&acc)[2][2][4][2], const Unit& u, int wr, int wc, int fr, int fq) const {
        const int row0 = u.pm * BM + wr * 64 + fr, col0 = u.pn * BM + wc * 32 + 8 * fq;
#pragma unroll
        for (int ai = 0; ai < 2; ++ai)
#pragma unroll
            for (int m = 0; m < 4; ++m) { const int row = row0 + ai * HALF + m * 16; const size_t off = (size_t)row * 1024 + col0; float sq = 0.f;
#pragma unroll
                for (int bj = 0; bj < 2; ++bj) {
                    const u32x4 b = *(const u32x4*)(xb + off + bj * HALF);
                    const f32x4 b0 = {__builtin_bit_cast(float, b.x << 16), __builtin_bit_cast(float, b.x & 0xffff0000u), __builtin_bit_cast(float, b.y << 16), __builtin_bit_cast(float, b.y & 0xffff0000u)};
                    const f32x4 b1 = {__builtin_bit_cast(float, b.z << 16), __builtin_bit_cast(float, b.z & 0xffff0000u), __builtin_bit_cast(float, b.w << 16), __builtin_bit_cast(float, b.w & 0xffff0000u)};
                    const f32x4 v0 = b0 + acc[ai][bj][m][0] * scale, v1 = b1 + acc[ai][bj][m][1] * scale;
                    u32x4 w; w.x = cvt_pk_bf16(v0[0], v0[1]); w.y = cvt_pk_bf16(v0[2], v0[3]); w.z = cvt_pk_bf16(v1[0], v1[1]); w.w = cvt_pk_bf16(v1[2], v1[3]);
                    *(u32x4*)(xb + off + bj * HALF) = w;
                    sq += ((v0[0] * v0[0] + v0[1] * v0[1]) + (v0[2] * v0[2] + v0[3] * v0[3])) + ((v1[0] * v1[0] + v1[1] * v1[1]) + (v1[2] * v1[2] + v1[3] * v1[3])); }
                sq += __shfl_xor(sq, 16); sq += __shfl_xor(sq, 32);
                if (fq == 0) ss[(size_t)row * 16 + u.pn * 4 + wc] = sq; }
    }
};
template <class Epi, class Sched, bool ALIGN_EPI = false, bool SP2 = false>
__device__ __forceinline__ void gemm_phase(PG8_LAS unsigned char* lds, const Gemm g, const Sched& S, const Epi& E) {
    int tid_ = threadIdx.x; asm volatile("" : "+v"(tid_));
    const int tid = tid_, wid = __builtin_amdgcn_readfirstlane(tid >> 6), lane = tid & 63, wr = wid >> 2, wc = wid & 3, fr = lane & 15, fq = lane >> 4;
    const int K = g.K, nt = K / BK;
    unsigned voffA[2], voffB[2];
#pragma unroll
    for (int i = 0; i < 2; ++i) { int R, C; stage_rc(tid * 16 + i * 8192, R, C); const int Rb = Epi::PERM ? ((R & ~31) + perm32(R & 31)) : R;
        voffA[i] = (unsigned)(R * K + C) * 2u; voffB[i] = (unsigned)(Rb * K + C) * 2u; }
    const size_t kstep = (size_t)(BK * 2);
    const size_t hstep = (size_t)HALF * K * 2;
    const size_t tstep = 2 * hstep;
    const unsigned ldsw = (unsigned)wid * 1024u;
    const int aoff = lds_byte(wr * 64 + fr, fq * 8), boff = lds_byte(wc * 32 + fr, fq * 8);
#define PG8_SA(b, h) (((b) * 2 + (h)) * HTB)
#define PG8_SB(b, h) ((4 + (b) * 2 + (h)) * HTB)
#define PG8_STAGE(bufoff, gbase, voff) do { _Pragma("unroll") for (int _i = 0; _i < 2; ++_i) \
        __builtin_amdgcn_global_load_lds((const unsigned*)((const char*)(gbase) + (voff)[_i]), (PG8_LAS unsigned*)(lds + (bufoff) + ldsw + _i * 8192), 16, 0, 0); } while (0)
#define PG8_LDA(dst, b, h) do { _Pragma("unroll") for (int m = 0; m < 4; ++m) _Pragma("unroll") for (int k = 0; k < 2; ++k) dst[m][k] = *(const PG8_LAS bf16x8*)(lds + PG8_SA(b, h) + aoff + m * 2048 + k * 1024); } while (0)
#define PG8_LDB(dst, b, h) do { _Pragma("unroll") for (int n = 0; n < 2; ++n) _Pragma("unroll") for (int k = 0; k < 2; ++k) dst[n][k] = *(const PG8_LAS bf16x8*)(lds + PG8_SB(b, h) + boff + n * 2048 + k * 1024); } while (0)
#define PG8_MMA(ai, bj, At, Bt) do { __builtin_amdgcn_s_setprio(1); _Pragma("unroll") for (int m = 0; m < 4; ++m) _Pragma("unroll") for (int n = 0; n < 2; ++n) _Pragma("unroll") for (int k = 0; k < 2; ++k) \
        acc[ai][bj][m][n] = __builtin_amdgcn_mfma_f32_16x16x32_bf16(Bt[n][k], At[m][k], acc[ai][bj][m][n], 0, 0, 0); __builtin_amdgcn_s_setprio(0); } while (0)
#define PG8_WAIT_V(n) asm volatile("s_waitcnt vmcnt(" #n ")" ::: "memory")
#define PG8_WAIT_L(n) asm volatile("s_waitcnt lgkmcnt(" #n ")" ::: "memory")
#define PG8_BAR __builtin_amdgcn_s_barrier()
#define PG8_SCHED __builtin_amdgcn_sched_barrier(0)
    Unit cur, nxt; int ui = 0, rs_pm = -1;
    if (!S.next(0, cur)) return;
    f32x4 acc[2][2][4][2];
#pragma unroll
    for (int a = 0; a < 2; ++a)
#pragma unroll
        for (int b = 0; b < 2; ++b)
#pragma unroll
            for (int m = 0; m < 4; ++m)
#pragma unroll
                for (int n = 0; n < 2; ++n) acc[a][b][m][n] = (f32x4){0.f, 0.f, 0.f, 0.f};
    bf16x8 At[4][2], B0[2][2], B1[2][2];
    const char* cA = (const char*)g.A + (size_t)cur.pm * tstep; const char* cB = (const char*)g.Bt + (size_t)cur.pn * tstep;
    S.a_ready(cur);
    if constexpr (SP2) {
        PG8_STAGE(PG8_SB(0, 0), cB, voffB); PG8_STAGE(PG8_SB(0, 1), cB + hstep, voffB); PG8_STAGE(PG8_SA(0, 0), cA, voffA); PG8_STAGE(PG8_SA(0, 1), cA + hstep, voffA);
        if (wr == 1) PG8_BAR;
        PG8_WAIT_V(2); PG8_BAR;
        PG8_STAGE(PG8_SB(1, 0), cB + kstep, voffB); PG8_STAGE(PG8_SA(1, 0), cA + kstep, voffA); PG8_STAGE(PG8_SB(1, 1), cB + hstep + kstep, voffB);
        PG8_WAIT_V(6); PG8_BAR;
    } else {
        PG8_STAGE(PG8_SB(0, 0), cB, voffB); PG8_STAGE(PG8_SA(0, 0), cA, voffA); PG8_STAGE(PG8_SB(0, 1), cB + hstep, voffB); PG8_STAGE(PG8_SA(0, 1), cA + hstep, voffA);
        if (wr == 1) PG8_BAR;
        PG8_WAIT_V(4); PG8_BAR;
        PG8_STAGE(PG8_SB(1, 0), cB + kstep, voffB); PG8_STAGE(PG8_SA(1, 0), cA + kstep, voffA); PG8_STAGE(PG8_SB(1, 1), cB + hstep + kstep, voffB);
        PG8_WAIT_V(6); PG8_BAR;
    }
    for (;;) {
        const bool has_next = S.next(ui + 1, nxt);
        const char* nA = has_next ? (const char*)g.A + (size_t)nxt.pm * tstep : cA; const char* nB = has_next ? (const char*)g.Bt + (size_t)nxt.pn * tstep : cB;
        for (int t = 0; t < nt; t += 2) {
            const bool last = (t == nt - 2);
            const char* a1 = cA + (size_t)(t + 1) * kstep;
            const char* a2 = last ? nA : cA + (size_t)(t + 2) * kstep; const char* b2 = last ? nB : cB + (size_t)(t + 2) * kstep;
            const char* a3 = a2 + kstep; const char* b3 = b2 + kstep;
            if (last && has_next) S.a_ready(nxt);
            if constexpr (SP2) {
            PG8_LDB(B0, 0, 0); PG8_LDB(B1, 0, 1); PG8_SCHED; PG8_LDA(At, 0, 0); PG8_STAGE(PG8_SA(1, 1), a1 + hstep, voffA);
            PG8_WAIT_V(8); PG8_WAIT_L(0); PG8_BAR; PG8_MMA(0, 0, At, B0); PG8_MMA(0, 1, At, B1); PG8_BAR; PG8_SCHED;
            PG8_LDA(At, 0, 1); PG8_STAGE(PG8_SB(0, 0), b2, voffB); PG8_STAGE(PG8_SB(0, 1), b2 + hstep, voffB); PG8_STAGE(PG8_SA(0, 0), a2, voffA);
            PG8_WAIT_V(8); PG8_WAIT_L(0); PG8_BAR; PG8_MMA(1, 0, At, B0); PG8_MMA(1, 1, At, B1); PG8_BAR; PG8_SCHED;
            PG8_LDB(B0, 1, 0); PG8_LDB(B1, 1, 1); PG8_SCHED; PG8_LDA(At, 1, 0); PG8_STAGE(PG8_SA(0, 1), a2 + hstep, voffA);
            PG8_WAIT_V(8); PG8_WAIT_L(0); PG8_BAR; PG8_MMA(0, 0, At, B0); PG8_MMA(0, 1, At, B1); PG8_BAR; PG8_SCHED;
            PG8_LDA(At, 1, 1); PG8_STAGE(PG8_SB(1, 0), b3, voffB); PG8_STAGE(PG8_SB(1, 1), b3 + hstep, voffB); PG8_STAGE(PG8_SA(1, 0), a3, voffA);
            PG8_WAIT_V(8); PG8_WAIT_L(0); PG8_BAR; PG8_MMA(1, 0, At, B0); PG8_MMA(1, 1, At, B1); PG8_BAR; PG8_SCHED;
            } else {
            PG8_LDB(B0, 0, 0); PG8_SCHED; PG8_LDA(At, 0, 0); PG8_STAGE(PG8_SA(1, 1), a1 + hstep, voffA);
            PG8_WAIT_L(8); PG8_BAR; PG8_WAIT_L(0); PG8_MMA(0, 0, At, B0); PG8_BAR; PG8_SCHED;
            PG8_LDB(B1, 0, 1); PG8_STAGE(PG8_SB(0, 0), b2, voffB);
            PG8_BAR; PG8_WAIT_L(0); PG8_MMA(0, 1, At, B1); PG8_BAR;
            PG8_LDA(At, 0, 1); PG8_STAGE(PG8_SA(0, 0), a2, voffA);
            PG8_BAR; PG8_WAIT_L(0); PG8_MMA(1, 0, At, B0); PG8_BAR; PG8_SCHED;
            PG8_STAGE(PG8_SB(0, 1), b2 + hstep, voffB);
            PG8_WAIT_V(6); PG8_BAR; PG8_MMA(1, 1, At, B1); PG8_BAR;
            PG8_LDB(B0, 1, 0); PG8_SCHED; PG8_LDA(At, 1, 0); PG8_STAGE(PG8_SA(0, 1), a2 + hstep, voffA);
            PG8_WAIT_L(8); PG8_BAR; PG8_WAIT_L(0); PG8_MMA(0, 0, At, B0); PG8_BAR; PG8_SCHED;
            PG8_LDB(B1, 1, 1); PG8_STAGE(PG8_SB(1, 0), b3, voffB);
            PG8_BAR; PG8_WAIT_L(0); PG8_MMA(0, 1, At, B1); PG8_BAR;
            PG8_LDA(At, 1, 1); PG8_STAGE(PG8_SA(1, 0), a3, voffA);
            PG8_BAR; PG8_WAIT_L(0); PG8_MMA(1, 0, At, B0); PG8_BAR; PG8_SCHED;
            PG8_STAGE(PG8_SB(1, 1), b3 + hstep, voffB);
            PG8_WAIT_V(6); PG8_BAR; PG8_MMA(1, 1, At, B1); PG8_BAR;
            }
        }
        if constexpr (ALIGN_EPI) { if (wr == 0) PG8_BAR; }
        if constexpr (Epi::RSTD) {
            static_assert(ALIGN_EPI, "the rstd table's barrier needs both half-workgroups at the same point");
            if (cur.pm != rs_pm) { if (tid < 256) ((PG8_LAS float*)(lds + STAGE_BYTES))[tid] = row_rstd(E.ss, cur.pm * BM + tid);
                asm volatile("s_waitcnt lgkmcnt(0)" ::: "memory"); PG8_BAR; asm volatile("" ::: "memory"); rs_pm = cur.pm; } }
        if constexpr (!Epi::AFTER_DRAIN) { E(acc, cur, wr, wc, fr, fq); S.done(cur); }
        if (!has_next) break;
#pragma unroll
        for (int a = 0; a < 2; ++a)
#pragma unroll
            for (int b = 0; b < 2; ++b)
#pragma unroll
                for (int m = 0; m < 4; ++m)
#pragma unroll
                    for (int n = 0; n < 2; ++n) acc[a][b][m][n] = (f32x4){0.f, 0.f, 0.f, 0.f};
        cur = nxt; cA = nA; cB = nB; ++ui;
        if constexpr (ALIGN_EPI) { if (wr == 1) PG8_BAR; }
    }
    PG8_WAIT_V(0);
    if constexpr (!ALIGN_EPI) { if (wr == 0) PG8_BAR; }
    PG8_BAR;
    if constexpr (Epi::AFTER_DRAIN) { E.fused(acc, cur, wr, wc, fr, fq, lds, wid, lane); S.done(cur); }
#undef PG8_SA
#undef PG8_SB
#undef PG8_STAGE
#undef PG8_LDA
#undef PG8_LDB
#undef PG8_MMA
#undef PG8_WAIT_V
#undef PG8_WAIT_L
#undef PG8_BAR
#undef PG8_SCHED
}
}
#define GAS __attribute__((address_space(1)))
#define LAS __attribute__((address_space(3)))
typedef unsigned short bf16;
typedef unsigned v4u __attribute__((ext_vector_type(4)));
typedef float f32x4 __attribute__((ext_vector_type(4)));
typedef short bf16x8 __attribute__((ext_vector_type(8)));
typedef GAS unsigned gu32;
typedef GAS unsigned long long gu64;
#define RLX_AGENT __ATOMIC_RELAXED, __HIP_MEMORY_SCOPE_AGENT
#define LDS_WAIT() asm volatile("s_waitcnt lgkmcnt(0)" ::: "memory")
#define VM_WAIT() asm volatile("s_waitcnt vmcnt(0)" ::: "memory")
__device__ __forceinline__ unsigned long long rt() { return __builtin_amdgcn_s_memrealtime(); }
__device__ __forceinline__ unsigned f2bf(float f) { unsigned u = __builtin_bit_cast(unsigned, f); return (u + 0x7fffu + ((u >> 16) & 1u)) >> 16; }
__device__ __forceinline__ unsigned pk2(float lo, float hi) { return pg8::cvt_pk_bf16(lo, hi); }

#define XB_TMO      128
#define XB_XCNT(j)  (256  + 64 * (j))
#define XB_XSUB(j)  (1280 + 64 * (j))
#define XB_XGEN(j)  (2304 + 64 * (j))
#define XB_TOP      3328
#define XB_TOPGEN   3392
#define XCD_BAR_WORDS 3456
#define XB_SPIN_CAP (1u << 18)

__device__ __forceinline__ unsigned xb_ld(unsigned* p)              { return __hip_atomic_load(p, __ATOMIC_RELAXED, __HIP_MEMORY_SCOPE_AGENT); }
__device__ __forceinline__ unsigned xb_add(unsigned* p, unsigned v) { return __hip_atomic_fetch_add(p, v, __ATOMIC_RELAXED, __HIP_MEMORY_SCOPE_AGENT); }
__device__ __forceinline__ unsigned xb_xcc_id() { return (unsigned)__builtin_amdgcn_s_getreg((3 << 11) | 20) & 0xFu; }
#define XB_SPIN(cond, bar) do { unsigned _sp = 0; while (cond) { __builtin_amdgcn_s_sleep(1); \
    if ((++_sp & 255u) == 0u) { if (xb_ld(&(bar)[XB_TMO])) break; if (_sp > XB_SPIN_CAP) { atomicAdd(&(bar)[XB_TMO], 1u); break; } } } } while (0)

struct XcdBarrier {
    unsigned* bar; unsigned x;
    volatile LAS unsigned* st;
};

__device__ __forceinline__ XcdBarrier xcd_barrier_post(unsigned* bar, volatile LAS unsigned* st) {
    XcdBarrier b; b.bar = bar; b.x = xb_xcc_id(); b.st = st;
    if (threadIdx.x == 0) (void)xb_add(&bar[XB_XCNT(b.x)], 1u);
    return b;
}
__device__ __forceinline__ void xcd_barrier_complete(unsigned* bar, unsigned x, unsigned& nloc, unsigned& nx) {
    const unsigned G = gridDim.x * gridDim.y * gridDim.z;
    unsigned sum, cnt, mine, sp = 0u;
    for (;;) {
        sum = 0u; cnt = 0u; mine = 0u;
#pragma unroll
        for (unsigned j = 0; j < 16; ++j) { const unsigned c = xb_ld(&bar[XB_XCNT(j)]); sum += c; cnt += (c > 0u) ? 1u : 0u; mine = (j == x) ? c : mine; }
        if (sum == G) break;
        __builtin_amdgcn_s_sleep(1);
        if ((++sp & 255u) == 0u) { if (xb_ld(&bar[XB_TMO])) break; if (sp > XB_SPIN_CAP) { atomicAdd(&bar[XB_TMO], 1u); break; } }
    }
    nloc = mine > 0u ? mine : 1u; nx = cnt > 0u ? cnt : 1u;
}

__device__ __forceinline__ void xcd_barrier(const XcdBarrier& b) {
    asm volatile("s_waitcnt vmcnt(0)" ::: "memory");
    __syncthreads();
    if (threadIdx.x == 0) {
        unsigned* bar = b.bar;
        __builtin_amdgcn_s_waitcnt(0);
        unsigned nloc = b.st[0], nx = b.st[1];
        if (nloc == 0u) { xcd_barrier_complete(bar, b.x, nloc, nx); b.st[0] = nloc; b.st[1] = nx; }
        const unsigned old = xb_add(&bar[XB_XSUB(b.x)], 1u);
        const unsigned gen = old / nloc;
        if (old + 1u == (gen + 1u) * nloc) {
            __builtin_amdgcn_fence(__ATOMIC_RELEASE, "agent");
            asm volatile("s_waitcnt vmcnt(0)" ::: "memory");
            const unsigned og = xb_add(&bar[XB_TOP], 1u);
            const unsigned tg = og / nx;
            if (og + 1u == (tg + 1u) * nx) xb_add(&bar[XB_TOPGEN], 1u);
            else XB_SPIN(xb_ld(&bar[XB_TOPGEN]) == tg, bar);
            __builtin_amdgcn_fence(__ATOMIC_ACQUIRE, "agent");
            xb_add(&bar[XB_XGEN(b.x)], 1u);
            asm volatile("s_waitcnt vmcnt(0)" ::: "memory");
        } else {
            XB_SPIN(xb_ld(&bar[XB_XGEN(b.x)]) == gen, bar);
            __builtin_amdgcn_fence(__ATOMIC_ACQUIRE, "agent");
            asm volatile("s_waitcnt vmcnt(0)" ::: "memory");
        }
    }
    __syncthreads();
}
constexpr int NWAVES = 8;
constexpr int NL = 2, NB = 16, NT = 2048, D = 1024, DFF = 2816, M = NB * NT;
constexpr int DIN = 3344, NP = 3584;
constexpr int PC_POOL = 0, PC_HG = 256, PC_RW = 1280, PC_RWX = 2048, PC_GL = 2304;
constexpr int N_PHASES = 18;
constexpr size_t MiB = 1u << 20;
constexpr size_t WS_CTL = 0, CTL_ZERO_BYTES = 64 * 1024;
constexpr size_t WS_SS = 1 * MiB;
constexpr size_t WS_W = 4 * MiB, W_LAYER = 42 * MiB;
constexpr size_t WO_1IN = 0, WO_1OUT = 11 * MiB, WO_IN = 16 * MiB + MiB / 2, WO_OUT = 23 * MiB + MiB / 2, WO_2IN = 25 * MiB + MiB / 2, WO_2OUT = 36 * MiB + MiB / 2;
constexpr size_t WS_XB = 88 * MiB;
constexpr size_t WS_Y = 152 * MiB;
constexpr size_t WS_HP = 216 * MiB;
constexpr size_t WS_LORA = 3 * MiB;
constexpr size_t WS_POOLW = WS_LORA + 256 * 1024;
constexpr size_t WS_END = 440 * MiB;
static_assert(WO_2OUT + (size_t)D * DFF * 2 == W_LAYER && WS_W + NL * W_LAYER == WS_XB && WS_HP + (size_t)M * NP * 2 == WS_END, "d_ws map");
constexpr int CW_BAR = 1024;
constexpr int RING_OFF = 0, RING_BYTES = 131072;
constexpr int LDS_BYTES = 163840;
constexpr int LDSCTL_OFF = LDS_BYTES - 1024, MISC_OFF = LDSCTL_OFF + 320;
struct Args { const float* in[30]; float* out; unsigned char* ws; int ph_lo, ph_hi; };
template <int I> __device__ __forceinline__ const float* kin() {
    const auto ka = __builtin_amdgcn_kernarg_segment_ptr(); const GAS float* p;
    asm volatile("s_load_dwordx2 %0, %1, %2\n\ts_waitcnt lgkmcnt(0)" : "=s"(p) : "s"(ka), "n"(I * 8) : "memory");
    return (const float*)p;
}
__device__ __forceinline__ int otid() { int t = threadIdx.x; asm volatile("" : "+v"(t)); return t; }
struct Frame {
    LAS unsigned char* lds; volatile LAS unsigned* MISC; gu32* ctl;
    int G, vcu;
    float* out; unsigned char* ws;
    bf16 *XB, *Y, *HP; float* SS;
};
__device__ __forceinline__ float wave_sum(float v) {
#pragma unroll
    for (int o = 1; o < 64; o <<= 1) v += __shfl_xor(v, o);
    return v;
}
__device__ __forceinline__ float bf_lo(unsigned u) { return __builtin_bit_cast(float, u << 16); }
__device__ __forceinline__ float bf_hi(unsigned u) { return __builtin_bit_cast(float, u & 0xffff0000u); }
__device__ __forceinline__ f32x4 ld_bf4(const bf16* p) { const uint2 u = *(const uint2*)p; return (f32x4){bf_lo(u.x), bf_hi(u.x), bf_lo(u.y), bf_hi(u.y)}; }
__device__ __forceinline__ void st_bf4(bf16* p, f32x4 v) { uint2 u; u.x = pk2(v[0], v[1]); u.y = pk2(v[2], v[3]); *(uint2*)p = u; }
using pg8::silu_f;
typedef unsigned u32x2 __attribute__((ext_vector_type(2)));
__device__ __forceinline__ float sigmoid_f(float x) { return __builtin_amdgcn_rcpf(1.0f + __expf(-x)); }
__device__ __forceinline__ float tanh_f(float x) { return 1.0f - 2.0f * __builtin_amdgcn_rcpf(__expf(2.0f * x) + 1.0f); }
template <int CTRL> __device__ __forceinline__ float dpp_f(float x) { return __builtin_bit_cast(float, __builtin_amdgcn_update_dpp(0, __builtin_bit_cast(int, x), CTRL, 0xF, 0xF, true)); }
__device__ __forceinline__ float red8(float x) { x += dpp_f<0xB1>(x); x += dpp_f<0x4E>(x); x += dpp_f<0x141>(x); return x; }
__device__ __forceinline__ float red16(float x) { x = red8(x); x += dpp_f<0x140>(x); return x; }

__device__ __forceinline__ void tr_item(const float* W, int ldw, int sc, const float* gain, const float* w2, bf16* WT, int K, int n0, int k0, LAS float* scr, int lane) {
    if (sc >= 0) {
        const float* src = W + (size_t)(k0 + (lane >> 4)) * ldw + sc + 4 * (lane & 15);
        f32x4 v[16];
#pragma unroll
        for (int i = 0; i < 16; ++i) v[i] = *(const f32x4*)(src + (size_t)(4 * i) * ldw);
#pragma unroll
        for (int i = 0; i < 16; ++i) { if (gain) v[i] = v[i] * gain[k0 + 4 * i + (lane >> 4)]; *(LAS f32x4*)(scr + (4 * i + (lane >> 4)) * 68 + 4 * (lane & 15)) = v[i]; }
    } else {
        const int c = -1 - sc + lane;
        float wv[16];
#pragma unroll
        for (int i = 0; i < 16; ++i) wv[i] = w2[i * 256 + c];
#pragma unroll 4
        for (int kk = 0; kk < 64; ++kk) { const float* wr_ = W + (size_t)(k0 + kk) * ldw + 3328; float v = 0.f;
#pragma unroll
            for (int j = 0; j < 16; ++j) v += wr_[j] * wv[j];
            scr[kk * 68 + lane] = v * gain[k0 + kk]; }
    }
    LDS_WAIT(); asm volatile("" ::: "memory");
#pragma unroll
    for (int k8 = 0; k8 < 8; ++k8) { const LAS float* s = scr + (8 * k8) * 68 + lane;
        v4u o; o.x = pk2(s[0 * 68], s[1 * 68]); o.y = pk2(s[2 * 68], s[3 * 68]); o.z = pk2(s[4 * 68], s[5 * 68]); o.w = pk2(s[6 * 68], s[7 * 68]);
        *(GAS v4u*)(WT + (size_t)(n0 + lane) * K + k0 + 8 * k8) = o; }
    LDS_WAIT(); asm volatile("" ::: "memory");
}
__device__ __forceinline__ int win_src_col(int n) {
    if (n < PC_HG) return n;
    if (n < PC_RW) { const int m = n - PC_HG, h = m >> 8, w = m & 255; return 256 + (w >> 6) * 256 + h * 64 + (w & 63); }
    if (n < PC_RWX) { const int m = n - PC_RW, h = m / 192, w = m % 192; return 1280 + (w >> 6) * 256 + h * 64 + (w & 63); }
    if (n < PC_GL) return n;
    { const int m = n - PC_GL, h = m / 320, w = m % 320, part = w >> 6, j = w & 63; if (part < 4) return 2304 + part * 256 + h * 64 + j; return -1 - (h * 64 + j); }
}
__device__ __forceinline__ void convert_weights(Frame& F, const Args& A, int l0, int l1, int gw, int NGW) {
    const int tid = otid(), lane = tid & 63, wave = __builtin_amdgcn_readfirstlane(tid >> 6);
    LAS float* scr = (LAS float*)(F.lds + RING_OFF + wave * 17408);
    constexpr int I_FIN = (D / 64) * (2 * DFF / 64), I_FOUT = (DFF / 64) * (D / 64), I_IN = (D / 64) * (NP / 64), I_OUT = (D / 64) * (D / 64);
    constexpr int I_LAYER = 2 * I_FIN + 2 * I_FOUT + I_IN + I_OUT;
    for (int it = l0 * I_LAYER + gw; it < l1 * I_LAYER; it += NGW) {
        const int l = it / I_LAYER; int r = it % I_LAYER;
        bf16* wl = (bf16*)(F.ws + WS_W + (size_t)l * W_LAYER);
        if (r < 2 * I_FIN) {
            const int which = r / I_FIN; r %= I_FIN; const int nblk = 2 * DFF / 64, kb = r / nblk, nb = r % nblk, n0 = 64 * nb, pn = n0 >> 8, w = n0 & 255;
            const int sc = (w < 128) ? 128 * pn + w : DFF + 128 * pn + (w - 128);
            tr_item((which ? kin<27>() : kin<2>()) + (size_t)l * D * 2 * DFF, 2 * DFF, sc, (which ? kin<26>() : kin<1>()) + l * D, nullptr, (bf16*)((char*)wl + (which ? WO_2IN : WO_1IN)), D, n0, 64 * kb, scr, lane);
            continue; }
        r -= 2 * I_FIN;
        if (r < 2 * I_FOUT) {
            const int which = r / I_FOUT; r %= I_FOUT; const int nblk = D / 64, kb = r / nblk, nb = r % nblk;
            tr_item((which ? kin<28>() : kin<3>()) + (size_t)l * DFF * D, D, 64 * nb, nullptr, nullptr, (bf16*)((char*)wl + (which ? WO_2OUT : WO_1OUT)), DFF, 64 * nb, 64 * kb, scr, lane);
            continue; }
        r -= 2 * I_FOUT;
        if (r < I_IN) {
            const int nblk = NP / 64, kb = r / nblk, nb = r % nblk;
            tr_item(kin<5>() + (size_t)l * D * DIN, DIN, win_src_col(64 * nb), kin<4>() + l * D, kin<23>() + l * 16 * 256, (bf16*)((char*)wl + WO_IN), D, 64 * nb, 64 * kb, scr, lane);
            continue; }
        r -= I_IN;
        { const int nblk = D / 64, kb = r / nblk, nb = r % nblk;
          tr_item(kin<6>() + (size_t)l * D * D, D, 64 * nb, nullptr, nullptr, (bf16*)((char*)wl + WO_OUT), D, 64 * nb, 64 * kb, scr, lane); }
    }
}
__device__ __forceinline__ void p0_prologue(Frame& F, const Args& A) {
    const int tid = otid(), lane = tid & 63, wave = __builtin_amdgcn_readfirstlane(tid >> 6);
    const int gw = F.vcu * NWAVES + wave, NGW = F.G * NWAVES;
    convert_weights(F, A, 0, 1, gw, NGW);
    for (int e = blockIdx.x * (NWAVES * 64) + tid; e < NL * 4 * 16384; e += F.G * NWAVES * 64) { const int lh = e >> 14, r = e & 16383, l = lh >> 2, h = lh & 3; float v;
        if (r < 4096) v = kin<14>()[((size_t)l * 64 + (r & 63)) * 256 + h * 64 + (r >> 6)];
        else if (r < 8192) v = kin<16>()[((size_t)l * 64 + (r & 63)) * 256 + h * 64 + ((r - 4096) >> 6)];
        else v = kin<17>()[((size_t)l * 128 + ((r - 8192) & 127)) * 256 + h * 64 + ((r - 8192) >> 7)];
        ((bf16*)(F.ws + WS_LORA))[e] = (bf16)f2bf(v); }
    for (int e = blockIdx.x * (NWAVES * 64) + tid; e < NL * 16384; e += F.G * NWAVES * 64) { const int l = e >> 14, r = e & 16383, g = r >> 12, d = (r >> 6) & 63, cc = r & 63;
        ((bf16*)(F.ws + WS_POOLW))[e] = (bf16)f2bf(kin<7>()[(size_t)l * 16384 + (g * 64 + cc) * 64 + d]); }
    const float* x = kin<0>();
    for (int m = gw; m < M; m += NGW) {
        const GAS f32x4* xr = (const GAS f32x4*)(x + (size_t)m * D) + lane; f32x4 v[4]; float s = 0.f;
#pragma unroll
        for (int j = 0; j < 4; ++j) { v[j] = xr[64 * j]; s += (v[j][0] * v[j][0] + v[j][1] * v[j][1]) + (v[j][2] * v[j][2] + v[j][3] * v[j][3]); }
        s = wave_sum(s);
        GAS unsigned long long* o8 = (GAS unsigned long long*)(F.XB + (size_t)m * D) + lane;
#pragma unroll
        for (int j = 0; j < 4; ++j) o8[64 * j] = (unsigned long long)pk2(v[j][0], v[j][1]) | ((unsigned long long)pk2(v[j][2], v[j][3]) << 32);
        if (lane < 16) F.SS[(size_t)m * 16 + lane] = (lane == 0) ? s : 0.f;
    }
}
typedef short s16x4 __attribute__((ext_vector_type(4)));
__device__ __forceinline__ f32x4 mfma16(bf16x8 a, bf16x8 b, f32x4 c) { return __builtin_amdgcn_mfma_f32_16x16x32_bf16(a, b, c, 0, 0, 0); }
__device__ __forceinline__ bf16x8 frag_rm(const LAS bf16* img, int pitch, int i0, int k0, int lane) { return *(const LAS bf16x8*)(img + (i0 + (lane & 15)) * pitch + k0 + 8 * (lane >> 4)); }
__device__ __forceinline__ bf16x8 frag_tr(const LAS bf16* img, int pitch, int i0, int k0, int lane) {
    LAS s16x4* a = (LAS s16x4*)(img + (k0 + 8 * (lane >> 4) + ((lane & 15) >> 2)) * pitch + i0 + 4 * (lane & 3));
    const s16x4 v0 = __builtin_amdgcn_ds_read_tr16_b64_v4i16(a), v1 = __builtin_amdgcn_ds_read_tr16_b64_v4i16((LAS s16x4*)((LAS bf16*)a + 4 * pitch));
    return (bf16x8){v0[0], v0[1], v0[2], v0[3], v1[0], v1[1], v1[2], v1[3]};
}
__device__ __forceinline__ float clamp80(float x) { return fminf(fmaxf(x, -80.f), 80.f); }
__device__ __forceinline__ void st_bf8(LAS bf16* p, const float (&v)[8]) { v4u w; w.x = pk2(v[0], v[1]); w.y = pk2(v[2], v[3]); w.z = pk2(v[4], v[5]); w.w = pk2(v[6], v[7]); *(LAS v4u*)p = w; }
__device__ __forceinline__ void ld_bf8g(const bf16* p, float (&v)[8]) { const v4u u = *(const v4u*)p; v[0] = bf_lo(u.x); v[1] = bf_hi(u.x); v[2] = bf_lo(u.y); v[3] = bf_hi(u.y); v[4] = bf_lo(u.z); v[5] = bf_hi(u.z); v[6] = bf_lo(u.w); v[7] = bf_hi(u.w); }
__device__ __forceinline__ void cvt_bf8(const v4u u, float (&v)[8]) { v[0] = bf_lo(u.x); v[1] = bf_hi(u.x); v[2] = bf_lo(u.y); v[3] = bf_hi(u.y); v[4] = bf_lo(u.z); v[5] = bf_hi(u.z); v[6] = bf_lo(u.w); v[7] = bf_hi(u.w); }
__device__ __forceinline__ u32x2 pk4(f32x4 v) { u32x2 w; w.x = pk2(v[0], v[1]); w.y = pk2(v[2], v[3]); return w; }

constexpr int CP = 72, CPF = 68;
constexpr int IMGB = 64 * CP * 2, ARRB = 64 * CPF * 4;
constexpr int G_Q = 0, G_K = IMGB, G_V = 2 * IMGB, G_PS = 3 * IMGB, G_ZT = 4 * IMGB, G_G = 5 * IMGB, G_TOT = G_G + ARRB, G_O = G_TOT + 8 * 64 * 4, G_END = G_O + ARRB;
static_assert(G_END <= RING_BYTES, "chunked GLA LDS map");
__device__ __forceinline__ void cumsum64(LAS float* G, LAS float* TOT, int wave, int lane) {
    float c[8]; float run = 0.f;
#pragma unroll
    for (int i = 0; i < 8; ++i) { run += G[(8 * wave + i) * CPF + lane]; c[i] = run; }
    TOT[wave * 64 + lane] = run;
    __syncthreads();
    float off = 0.f;
#pragma unroll
    for (int q = 0; q < 7; ++q) off += (q < wave) ? TOT[q * 64 + lane] : 0.f;
#pragma unroll
    for (int i = 0; i < 8; ++i) G[(8 * wave + i) * CPF + lane] = c[i] + off;
    __syncthreads();
}
template <int MIX> __device__ __forceinline__ void glalike_chunk_item(Frame& F, int l, int b, int h) {
    LAS bf16* iQ = (LAS bf16*)(F.lds + G_Q); LAS bf16* iK = (LAS bf16*)(F.lds + G_K); LAS bf16* iV = (LAS bf16*)(F.lds + G_V); LAS bf16* iPS = (LAS bf16*)(F.lds + G_PS); LAS bf16* iZT = (LAS bf16*)(F.lds + G_ZT);
    LAS float* fG = (LAS float*)(F.lds + G_G); LAS float* fTOT = (LAS float*)(F.lds + G_TOT); LAS float* fO = (LAS float*)(F.lds + G_O);
    const int tid = otid(), lane = tid & 63, wave = __builtin_amdgcn_readfirstlane(tid >> 6), fr = lane & 15, fq = lane >> 4;
    const int t = tid >> 3, j8 = tid & 7, ch = h * 64 + 8 * j8;
    const int pc = (MIX == 0) ? PC_HG + h * 256 : PC_GL + h * 320;
    float cst0[8], cst1[8];
    if (MIX == 0) {
#pragma unroll
        for (int i = 0; i < 8; ++i) { cst0[i] = (l == 0) ? 0.f : __builtin_amdgcn_rcpf(1.0f + __expf(kin<10>()[ch + i] - kin<10>()[256 + ch + i])); cst1[i] = 0.f; }
    } else {
#pragma unroll
        for (int i = 0; i < 8; ++i) { cst0[i] = kin<24>()[l * 256 + ch + i]; cst1[i] = kin<25>()[l * 256 + ch + i]; }
    }
    const int kt = wave >> 1, vt0 = 2 * (wave & 1);
    f32x4 Z[2] = {{0.f, 0.f, 0.f, 0.f}, {0.f, 0.f, 0.f, 0.f}};
    const bf16* prow = F.HP + ((size_t)b * NT + t) * NP + pc + 8 * j8;
    v4u rq = *(const v4u*)prow, r1 = *(const v4u*)(prow + 64), rv = *(const v4u*)(prow + 128), r3 = *(const v4u*)(prow + 192), r4 = (MIX == 2) ? *(const v4u*)(prow + 256) : rq;
    for (int c = 0; c < NT / 64; ++c) {
        float xq[8], x1[8], xv[8], gg[8], qx[8], kx[8];
        cvt_bf8(rq, xq); cvt_bf8(r1, x1); cvt_bf8(r3, gg);
        {
            float lg[8];
            if (MIX == 0) {
#pragma unroll
                for (int i = 0; i < 8; ++i) { const float f = cst0[i] + (1.0f - cst0[i]) * sigmoid_f(x1[i]); lg[i] = 0.6931471806f * __builtin_amdgcn_logf(fmaxf(f, 1e-30f)); kx[i] = 1.0f - f; qx[i] = silu_f(xq[i]) * 0.125f; }
            } else {
                float ga[8]; cvt_bf8(r4, ga);
#pragma unroll
                for (int i = 0; i < 8; ++i) { const float x = ga[i] + cst0[i]; lg[i] = (fminf(x, 0.f) - 0.6931471806f * __builtin_amdgcn_logf(1.0f + __expf(-fabsf(x)))) * 0.0625f; kx[i] = x1[i]; qx[i] = xq[i] * 0.125f; }
            }
            *(LAS f32x4*)(fG + t * CPF + 8 * j8) = (f32x4){lg[0], lg[1], lg[2], lg[3]}; *(LAS f32x4*)(fG + t * CPF + 8 * j8 + 4) = (f32x4){lg[4], lg[5], lg[6], lg[7]};
            *(LAS v4u*)(iV + t * CP + 8 * j8) = rv;
        }
        if (c + 1 < NT / 64) { const bf16* pn = prow + (size_t)(c + 1) * 64 * NP;
            rq = *(const v4u*)pn; r1 = *(const v4u*)(pn + 64); rv = *(const v4u*)(pn + 128); r3 = *(const v4u*)(pn + 192); if (MIX == 2) r4 = *(const v4u*)(pn + 256); }
        __syncthreads();
        cumsum64(fG, fTOT, wave, lane);
        {
            const f32x4 b0 = *(const LAS f32x4*)(fG + t * CPF + 8 * j8), b1 = *(const LAS f32x4*)(fG + t * CPF + 8 * j8 + 4);
            const f32x4 p0 = *(const LAS f32x4*)(fG + 31 * CPF + 8 * j8), p1 = *(const LAS f32x4*)(fG + 31 * CPF + 8 * j8 + 4);
            float qt[8], ktv[8];
#pragma unroll
            for (int i = 0; i < 4; ++i) { qt[i] = qx[i] * __expf(clamp80(b0[i] - p0[i])); qt[4 + i] = qx[4 + i] * __expf(clamp80(b1[i] - p1[i]));
                ktv[i] = kx[i] * __expf(clamp80(p0[i] - b0[i])); ktv[4 + i] = kx[4 + i] * __expf(clamp80(p1[i] - b1[i])); }
            st_bf8(iQ + t * CP + 8 * j8, qt); st_bf8(iK + t * CP + 8 * j8, ktv);
            const f32x4 er = *(const LAS f32x4*)(fG + 31 * CPF + 16 * kt + 4 * fq);
#pragma unroll
            for (int i = 0; i < 2; ++i) { f32x4 zs;
#pragma unroll
                for (int rg = 0; rg < 4; ++rg) zs[rg] = Z[i][rg] * __expf(er[rg]);
                *(LAS u32x2*)(iZT + (16 * (vt0 + i) + fr) * CP + 16 * kt + 4 * fq) = pk4(zs); }
        }
        __syncthreads();
        {
            const int st = kt;
#pragma unroll
            for (int i = 0; i < 2; ++i) { const int tt = vt0 + i; f32x4 acc = {0.f, 0.f, 0.f, 0.f};
                if (st <= tt) {
#pragma unroll
                    for (int ks = 0; ks < 2; ++ks) acc = mfma16(frag_rm(iK, CP, 16 * st, 32 * ks, lane), frag_rm(iQ, CP, 16 * tt, 32 * ks, lane), acc);
#pragma unroll
                    for (int rg = 0; rg < 4; ++rg) if (16 * st + 4 * fq + rg > 16 * tt + fr) acc[rg] = 0.f;
                }
                *(LAS u32x2*)(iPS + (16 * tt + fr) * CP + 16 * st + 4 * fq) = pk4(acc); }
        }
        __syncthreads();
        {
            const int vt = kt;
#pragma unroll
            for (int i = 0; i < 2; ++i) { const int tt = vt0 + i; f32x4 acc = {0.f, 0.f, 0.f, 0.f};
#pragma unroll
                for (int ks = 0; ks < 2; ++ks) { acc = mfma16(frag_tr(iV, CP, 16 * vt, 32 * ks, lane), frag_rm(iPS, CP, 16 * tt, 32 * ks, lane), acc);
                    acc = mfma16(frag_rm(iZT, CP, 16 * vt, 32 * ks, lane), frag_rm(iQ, CP, 16 * tt, 32 * ks, lane), acc); }
                *(LAS f32x4*)(fO + (16 * tt + fr) * CPF + 16 * vt + 4 * fq) = acc; }
            const f32x4 bc = *(const LAS f32x4*)(fG + 63 * CPF + 16 * kt + 4 * fq), er = *(const LAS f32x4*)(fG + 31 * CPF + 16 * kt + 4 * fq);
#pragma unroll
            for (int i = 0; i < 2; ++i) { f32x4 acc = {0.f, 0.f, 0.f, 0.f};
#pragma unroll
                for (int ks = 0; ks < 2; ++ks) acc = mfma16(frag_tr(iK, CP, 16 * kt, 32 * ks, lane), frag_tr(iV, CP, 16 * (vt0 + i), 32 * ks, lane), acc);
#pragma unroll
                for (int rg = 0; rg < 4; ++rg) Z[i][rg] = __expf(bc[rg]) * Z[i][rg] + __expf(bc[rg] - er[rg]) * acc[rg]; }
        }
        __syncthreads();
        {
            const size_t row = (size_t)b * NT + c * 64 + t;
            const f32x4 o0 = *(const LAS f32x4*)(fO + t * CPF + 8 * j8), o1 = *(const LAS f32x4*)(fO + t * CPF + 8 * j8 + 4);
            float y[8];
            if (MIX == 0) {
#pragma unroll
                for (int i = 0; i < 4; ++i) { y[i] = o0[i]; y[4 + i] = o1[i]; }
                v4u w; w.x = pk2(y[0], y[1]); w.y = pk2(y[2], y[3]); w.z = pk2(y[4], y[5]); w.w = pk2(y[6], y[7]); *(v4u*)(F.Y + row * D + 256 + ch) = w;
            } else {
                const float ms = red8(((o0[0] * o0[0] + o0[1] * o0[1]) + (o0[2] * o0[2] + o0[3] * o0[3])) + ((o1[0] * o1[0] + o1[1] * o1[1]) + (o1[2] * o1[2] + o1[3] * o1[3]))) * (1.0f / 64.0f);
                const float rs = __builtin_amdgcn_rsqf(ms + 1e-6f);
#pragma unroll
                for (int i = 0; i < 4; ++i) { y[i] = o0[i] * rs * cst1[i] * silu_f(gg[i]); y[4 + i] = o1[i] * rs * cst1[4 + i] * silu_f(gg[4 + i]); }
                v4u w; w.x = pk2(y[0], y[1]); w.y = pk2(y[2], y[3]); w.z = pk2(y[4], y[5]); w.w = pk2(y[6], y[7]); *(v4u*)(F.Y + row * D + 768 + ch) = w;
            }
        }
    }
    __syncthreads();
}
constexpr int SLOT = 64 * CP * 2;
constexpr int R_FA = 12 * SLOT, R_FB = R_FA + ARRB, R_TOT = R_FB + ARRB, R_END = R_TOT + 8 * 64 * 4;
static_assert(R_END <= LDSCTL_OFF, "chunked RWKV LDS map");
constexpr int R_TAB = R_END;
static_assert(R_TAB + 2304 * 4 <= LDSCTL_OFF, "RWKV constant table");
__device__ __forceinline__ void rwkv_fill_tab(Frame& F, int l, int tid) {
    LAS float* tab = (LAS float*)(F.lds + R_TAB);
    for (int i = tid; i < 1024; i += NWAVES * 64) tab[i] = kin<12>()[l * 1024 + i];
    if (tid < 256) { tab[1024 + tid] = kin<13>()[l * 256 + tid]; tab[1280 + tid] = kin<15>()[l * 256 + tid]; tab[1536 + tid] = kin<18>()[l * 256 + tid]; tab[1792 + tid] = kin<19>()[l * 256 + tid]; tab[2048 + tid] = kin<20>()[l * 256 + tid]; }
    __syncthreads();
}
constexpr size_t XS_UNIT = 32768, XS2_UNIT = 16384, XS2_OFF = 64 * MiB;
struct RwPre { v4u c[7], p[7]; float pm; };
__device__ __forceinline__ void rw_prefetch(Frame& F, int b, int h, int c, int tid, RwPre& q) {
    const int t = tid >> 3, j8 = tid & 7, tpos = c * 64 + t; const bf16* cur = F.HP + ((size_t)b * NT + tpos) * NP; const bf16* prv = (tpos > 0) ? cur - NP : cur; q.pm = (tpos > 0) ? 1.0f : 0.0f;
    const int off[7] = {PC_RW + h * 192 + 8 * j8, PC_RW + h * 192 + 64 + 8 * j8, PC_RW + h * 192 + 128 + 8 * j8, PC_RWX + 8 * j8, PC_RWX + 64 + 8 * j8, PC_RWX + 128 + 16 * j8, PC_RWX + 136 + 16 * j8};
#pragma unroll
    for (int i = 0; i < 7; ++i) { q.c[i] = *(const v4u*)(cur + off[i]); q.p[i] = *(const v4u*)(prv + off[i]); }
}
__device__ __forceinline__ void rwkv_chunk_unit(Frame& F, int l, int b, int h, int c, RwPre& pre, bool has_next, int nb, int nh, int nc) {
    const int tid = otid(), lane = tid & 63, wave = __builtin_amdgcn_readfirstlane(tid >> 6), fr = lane & 15, fq = lane >> 4;
    const int t = tid >> 3, j8 = tid & 7, ch = h * 64 + 8 * j8;
    const int kt = wave >> 1, vt0 = 2 * (wave & 1);
#define SL(i) ((LAS bf16*)(F.lds + (i) * SLOT))
    LAS bf16* iXW = SL(0); LAS bf16* iXA = SL(1); LAS bf16* iXG = SL(2); LAS bf16* iW2 = SL(4); LAS bf16* iA2 = SL(5); LAS bf16* iG2 = SL(6);
    LAS bf16* iAp = SL(0); LAS bf16* iRp = SL(1); LAS bf16* iBt = SL(2); LAS bf16* iKt = SL(3); LAS bf16* iV = SL(8);
    LAS bf16* iAab = SL(4); LAS bf16* iAak = SL(5); LAS bf16* iArb = SL(6); LAS bf16* iArk = SL(7);
    LAS bf16* iT = SL(9); LAS bf16* iX1 = SL(10); LAS bf16* iM = SL(11); LAS bf16* iWh = SL(3); LAS bf16* iUh = SL(5);
    LAS float* fC = (LAS float*)(F.lds + R_FA); LAS float* fB = (LAS float*)(F.lds + R_FB); LAS float* fTOT = (LAS float*)(F.lds + R_TOT);
    const int unit = (b * 4 + h) * (NT / 64) + c;
    unsigned char* xs = (unsigned char*)F.out + (size_t)unit * XS_UNIT; unsigned char* xs2 = (unsigned char*)F.out + XS2_OFF + (size_t)unit * XS2_UNIT;
    float xr[8], xk[8], xv[8];
    {
        const float pm = pre.pm;
        const LAS float* mu = (const LAS float*)(F.lds + R_TAB);
        const bf16* lw = (const bf16*)(F.ws + WS_LORA) + (size_t)(l * 4 + h) * 16384;
        const int wn = tid >> 3, wk8 = (tid & 7) * 8, wk16 = (tid & 7) * 16;
        const v4u wq0 = *(const v4u*)(lw + wn * 64 + wk8), wq1 = *(const v4u*)(lw + 4096 + wn * 64 + wk8), wq2 = *(const v4u*)(lw + 8192 + wn * 128 + wk16), wq3 = *(const v4u*)(lw + 8192 + wn * 128 + wk16 + 8);
        float a_[8], p_[8], o_[8];
#define SHIFT(dst, idx, muoff) do { cvt_bf8(pre.c[idx], a_); cvt_bf8(pre.p[idx], p_); const f32x4 m0_ = *(const LAS f32x4*)(mu + (muoff)), m1_ = *(const LAS f32x4*)(mu + (muoff) + 4); \
            _Pragma("unroll") for (int i = 0; i < 4; ++i) { dst[i] = a_[i] + (p_[i] * pm - a_[i]) * m0_[i]; dst[4 + i] = a_[4 + i] + (p_[4 + i] * pm - a_[4 + i]) * m1_[i]; } } while (0)
        SHIFT(xr, 0, ch); SHIFT(xk, 1, 256 + ch); SHIFT(xv, 2, 512 + ch);
        st_bf8(iV + t * CP + 8 * j8, xv);
        SHIFT(o_, 3, 768 + 8 * j8);
#pragma unroll
        for (int i = 0; i < 8; ++i) o_[i] = tanh_f(o_[i]);
        st_bf8(iXW + t * CP + 8 * j8, o_);
        SHIFT(o_, 4, 832 + 8 * j8); st_bf8(iXA + t * CP + 8 * j8, o_);
        SHIFT(o_, 5, 896 + 16 * j8);
#pragma unroll
        for (int i = 0; i < 8; ++i) o_[i] = sigmoid_f(o_[i]);
        st_bf8(iXG + t * 136 + 16 * j8, o_);
        SHIFT(o_, 6, 904 + 16 * j8);
#pragma unroll
        for (int i = 0; i < 8; ++i) o_[i] = sigmoid_f(o_[i]);
        st_bf8(iXG + t * 136 + 16 * j8 + 8, o_);
#undef SHIFT
        *(LAS v4u*)(iW2 + wn * CP + wk8) = wq0; *(LAS v4u*)(iA2 + wn * CP + wk8) = wq1; *(LAS v4u*)(iG2 + wn * 136 + wk16) = wq2; *(LAS v4u*)(iG2 + wn * 136 + wk16 + 8) = wq3;
        if (has_next) rw_prefetch(F, nb, nh, nc, tid, pre);
    }
    __syncthreads();
    {
        const int nt = kt;
        const f32x4 w0v = *(const LAS f32x4*)((const LAS float*)(F.lds + R_TAB) + 1024 + h * 64 + 16 * nt + 4 * fq), a0v = *(const LAS f32x4*)((const LAS float*)(F.lds + R_TAB) + 1280 + h * 64 + 16 * nt + 4 * fq);
#pragma unroll
        for (int i = 0; i < 2; ++i) { const int tt = vt0 + i; f32x4 cw = {0.f, 0.f, 0.f, 0.f}, ca = cw, cg = cw;
#pragma unroll
            for (int ks = 0; ks < 2; ++ks) { cw = mfma16(frag_rm(iW2, CP, 16 * nt, 32 * ks, lane), frag_rm(iXW, CP, 16 * tt, 32 * ks, lane), cw);
                ca = mfma16(frag_rm(iA2, CP, 16 * nt, 32 * ks, lane), frag_rm(iXA, CP, 16 * tt, 32 * ks, lane), ca); }
#pragma unroll
            for (int ks = 0; ks < 4; ++ks) cg = mfma16(frag_rm(iG2, 136, 16 * nt, 32 * ks, lane), frag_rm(iXG, 136, 16 * tt, 32 * ks, lane), cg);
            f32x4 lwv, av;
#pragma unroll
            for (int rg = 0; rg < 4; ++rg) { lwv[rg] = -0.6065306597f * sigmoid_f(w0v[rg] + cw[rg]); av[rg] = sigmoid_f(a0v[rg] + ca[rg]); }
            *(LAS f32x4*)(fC + (16 * tt + fr) * CPF + 16 * nt + 4 * fq) = lwv; *(LAS f32x4*)(fB + (16 * tt + fr) * CPF + 16 * nt + 4 * fq) = av;
            *(u32x2*)((bf16*)xs2 + (16 * tt + fr) * 64 + 16 * nt + 4 * fq) = pk4(cg); }
    }
    __syncthreads();
    float lw8[8], a8[8];
    { const f32x4 u0 = *(const LAS f32x4*)(fC + t * CPF + 8 * j8), u1 = *(const LAS f32x4*)(fC + t * CPF + 8 * j8 + 4), v0 = *(const LAS f32x4*)(fB + t * CPF + 8 * j8), v1 = *(const LAS f32x4*)(fB + t * CPF + 8 * j8 + 4);
#pragma unroll
      for (int i = 0; i < 4; ++i) { lw8[i] = u0[i]; lw8[4 + i] = u1[i]; a8[i] = v0[i]; a8[4 + i] = v1[i]; } }
    __syncthreads();
    cumsum64(fC, fTOT, wave, lane);
    {
        const f32x4 c0 = *(const LAS f32x4*)(fC + t * CPF + 8 * j8), c1 = *(const LAS f32x4*)(fC + t * CPF + 8 * j8 + 4), p0 = *(const LAS f32x4*)(fC + 31 * CPF + 8 * j8), p1 = *(const LAS f32x4*)(fC + 31 * CPF + 8 * j8 + 4);
        float kk[8], n2 = 0.f, bon = 0.f, kx[8], ckk[8], cka[8], crk[8];
        { const LAS float* q18 = (const LAS float*)(F.lds + R_TAB) + 1536 + ch; const LAS float* q19 = q18 + 256; const LAS float* q20 = q18 + 512;
          const f32x4 a0_ = *(const LAS f32x4*)q18, a1_ = *(const LAS f32x4*)(q18 + 4), b0_ = *(const LAS f32x4*)q19, b1_ = *(const LAS f32x4*)(q19 + 4), c0_ = *(const LAS f32x4*)q20, c1_ = *(const LAS f32x4*)(q20 + 4);
#pragma unroll
          for (int i = 0; i < 4; ++i) { ckk[i] = a0_[i]; ckk[4 + i] = a1_[i]; cka[i] = b0_[i]; cka[4 + i] = b1_[i]; crk[i] = c0_[i]; crk[4 + i] = c1_[i]; } }
#pragma unroll
        for (int i = 0; i < 8; ++i) { kk[i] = xk[i] * ckk[i]; n2 += kk[i] * kk[i]; kx[i] = xk[i] * (1.0f + (a8[i] - 1.0f) * cka[i]); bon += xr[i] * kx[i] * crk[i]; }
        n2 = red8(n2); bon = red8(bon); const float inv = 1.0f / fmaxf(sqrtf(n2), 1e-12f);
        float o_[8];
#pragma unroll
        for (int i = 0; i < 8; ++i) o_[i] = bon * xv[i];
        { v4u w; w.x = pk2(o_[0], o_[1]); w.y = pk2(o_[2], o_[3]); w.z = pk2(o_[4], o_[5]); w.w = pk2(o_[6], o_[7]); *(v4u*)((bf16*)xs2 + 4096 + t * 64 + 8 * j8) = w; }
        float cc[8], rho[8];
#pragma unroll
        for (int i = 0; i < 4; ++i) { cc[i] = c0[i]; cc[4 + i] = c1[i]; rho[i] = p0[i]; rho[4 + i] = p1[i]; }
#pragma unroll
        for (int i = 0; i < 8; ++i) o_[i] = kk[i] * inv * __expf(clamp80(cc[i] - lw8[i] - rho[i]));
        st_bf8(iAp + t * CP + 8 * j8, o_);
#pragma unroll
        for (int i = 0; i < 8; ++i) o_[i] = xr[i] * __expf(clamp80(cc[i] - rho[i]));
        st_bf8(iRp + t * CP + 8 * j8, o_);
#pragma unroll
        for (int i = 0; i < 8; ++i) { const float ek = __expf(clamp80(rho[i] - cc[i])); o_[i] = kk[i] * inv * a8[i] * ek; kx[i] *= ek; }
        st_bf8(iBt + t * CP + 8 * j8, o_); st_bf8(iKt + t * CP + 8 * j8, kx);
        for (int i = tid; i < SLOT / 16; i += NWAVES * 64) { *(LAS v4u*)((LAS unsigned char*)iT + i * 16) = (v4u){0u, 0u, 0u, 0u}; *(LAS v4u*)((LAS unsigned char*)iM + i * 16) = (v4u){0u, 0u, 0u, 0u}; }
    }
    __syncthreads();
    {
        const int it = kt;
#pragma unroll
        for (int i = 0; i < 2; ++i) { const int tt = vt0 + i; f32x4 ab = {0.f, 0.f, 0.f, 0.f}, ak = ab, rb = ab, rk = ab;
            if (it <= tt) {
#pragma unroll
                for (int ks = 0; ks < 2; ++ks) { const bf16x8 fb = frag_rm(iBt, CP, 16 * it, 32 * ks, lane), fk = frag_rm(iKt, CP, 16 * it, 32 * ks, lane), fa = frag_rm(iAp, CP, 16 * tt, 32 * ks, lane), fr_ = frag_rm(iRp, CP, 16 * tt, 32 * ks, lane);
                    ab = mfma16(fb, fa, ab); ak = mfma16(fk, fa, ak); rb = mfma16(fb, fr_, rb); rk = mfma16(fk, fr_, rk); }
#pragma unroll
                for (int rg = 0; rg < 4; ++rg) { const int ii = 16 * it + 4 * fq + rg, tq = 16 * tt + fr; if (ii >= tq) { ab[rg] = 0.f; ak[rg] = 0.f; } if (ii > tq) { rb[rg] = 0.f; rk[rg] = 0.f; } }
            }
            const int o = (16 * tt + fr) * CP + 16 * it + 4 * fq;
            *(LAS u32x2*)(iAab + o) = pk4(ab); *(LAS u32x2*)(iAak + o) = pk4(ak); *(LAS u32x2*)(iArb + o) = pk4(rb); *(LAS u32x2*)(iArk + o) = pk4(rk);
            if (it == tt) {
#pragma unroll
                for (int rg = 0; rg < 4; ++rg) fB[(16 * it + 4 * fq + rg) * CPF + 16 * tt + fr] = ab[rg]; } }
    }
    __syncthreads();
    f32x4 accO[2], accQ[2];
    {
        const int vt = kt;
#pragma unroll
        for (int i = 0; i < 2; ++i) { const int tt = vt0 + i; f32x4 x1 = {0.f, 0.f, 0.f, 0.f}; accO[i] = x1; accQ[i] = x1;
#pragma unroll
            for (int ks = 0; ks < 2; ++ks) { const bf16x8 fv = frag_tr(iV, CP, 16 * vt, 32 * ks, lane);
                x1 = mfma16(fv, frag_rm(iAak, CP, 16 * tt, 32 * ks, lane), x1); accO[i] = mfma16(fv, frag_rm(iArk, CP, 16 * tt, 32 * ks, lane), accO[i]);
                accQ[i] = mfma16(frag_tr(iKt, CP, 16 * kt, 32 * ks, lane), frag_tr(iV, CP, 16 * (vt0 + i), 32 * ks, lane), accQ[i]); }
            *(LAS u32x2*)(iX1 + (16 * tt + fr) * CP + 16 * vt + 4 * fq) = pk4(x1); }
        if (wave == 0) {
            const int blk = lane >> 4, j = lane & 15; float x[16];
#pragma unroll
            for (int tq = 0; tq < 16; ++tq) x[tq] = (tq == j) ? 1.0f : 0.0f;
            const LAS float* at = fB + (16 * blk) * CPF + 16 * blk;
#pragma unroll
            for (int i = 0; i < 15; ++i) {
                const f32x4 r0 = *(const LAS f32x4*)(at + i * CPF), r1 = *(const LAS f32x4*)(at + i * CPF + 4), r2 = *(const LAS f32x4*)(at + i * CPF + 8), r3 = *(const LAS f32x4*)(at + i * CPF + 12);
                const float ar[16] = {r0[0], r0[1], r0[2], r0[3], r1[0], r1[1], r1[2], r1[3], r2[0], r2[1], r2[2], r2[3], r3[0], r3[1], r3[2], r3[3]};
#pragma unroll
                for (int tq = i + 1; tq < 16; ++tq) x[tq] -= ar[tq] * x[i]; }
#pragma unroll
            for (int tq = 0; tq < 16; ++tq) iT[(16 * blk + tq) * CP + 16 * blk + j] = (bf16)f2bf(x[tq]);
        }
    }
    __syncthreads();
    if (wave < 2) {
        const int o = 32 * wave; f32x4 m = {0.f, 0.f, 0.f, 0.f};
        m = mfma16(frag_tr(iT, CP, o, o, lane), frag_rm(iAab, CP, o + 16, o, lane), m);
        *(LAS u32x2*)(iM + (o + 16 + fr) * CP + o + 4 * fq) = pk4(m); }
    __syncthreads();
    if (wave < 2) {
        const int o = 32 * wave; f32x4 m = {0.f, 0.f, 0.f, 0.f};
        m = mfma16(frag_tr(iM, CP, o, o, lane), frag_rm(iT, CP, o + 16, o, lane), m);
        *(LAS u32x2*)(iT + (o + 16 + fr) * CP + o + 4 * fq) = pk4(-m); }
    __syncthreads();
    if (wave < 4) {
        const int jt = wave >> 1, tt = wave & 1; f32x4 m = {0.f, 0.f, 0.f, 0.f};
        m = mfma16(frag_tr(iT, CP, 16 * jt, 0, lane), frag_rm(iAab, CP, 32 + 16 * tt, 0, lane), m);
        *(LAS u32x2*)(iM + (16 * tt + fr) * CP + 16 * jt + 4 * fq) = pk4(m); }
    __syncthreads();
    if (wave < 4) {
        const int jt = wave >> 1, tt = wave & 1; f32x4 m = {0.f, 0.f, 0.f, 0.f};
        m = mfma16(frag_tr(iM, CP, 16 * jt, 0, lane), frag_rm(iT, CP, 32 + 16 * tt, 32, lane), m);
        *(LAS u32x2*)(iT + (32 + 16 * tt + fr) * CP + 16 * jt + 4 * fq) = pk4(-m); }
    __syncthreads();
    {
#pragma unroll
        for (int i = 0; i < 2; ++i) { const int tt = vt0 + i; f32x4 w = {0.f, 0.f, 0.f, 0.f}, u = w;
#pragma unroll
            for (int ks = 0; ks < 2; ++ks) { const bf16x8 ft = frag_rm(iT, CP, 16 * tt, 32 * ks, lane);
                w = mfma16(frag_tr(iAp, CP, 16 * kt, 32 * ks, lane), ft, w); u = mfma16(frag_tr(iX1, CP, 16 * kt, 32 * ks, lane), ft, u); }
            *(LAS u32x2*)(iWh + (16 * tt + fr) * CP + 16 * kt + 4 * fq) = pk4(w); *(LAS u32x2*)(iUh + (16 * tt + fr) * CP + 16 * kt + 4 * fq) = pk4(u); }
    }
    __syncthreads();
    {
        const f32x4 rho4 = *(const LAS f32x4*)(fC + 31 * CPF + 16 * kt + 4 * fq), cC4 = *(const LAS f32x4*)(fC + 63 * CPF + 16 * kt + 4 * fq);
        f32x4 dr4, de4;
#pragma unroll
        for (int rg = 0; rg < 4; ++rg) { dr4[rg] = __expf(rho4[rg]); de4[rg] = __expf(cC4[rg] - rho4[rg]); }
#pragma unroll
        for (int i = 0; i < 2; ++i) { const int xt = vt0 + i;
            f32x4 p = {0.f, 0.f, 0.f, 0.f}, q = p, r = p, o = p;
#pragma unroll
            for (int ks = 0; ks < 2; ++ks) { const bf16x8 fw = frag_tr(iWh, CP, 16 * kt, 32 * ks, lane), fbk = frag_tr(iBt, CP, 16 * kt, 32 * ks, lane), fu = frag_tr(iUh, CP, 16 * xt, 32 * ks, lane), fa = frag_rm(iArb, CP, 16 * xt, 32 * ks, lane);
                p = mfma16(fw, frag_tr(iBt, CP, 16 * xt, 32 * ks, lane), p);
                q = mfma16(fbk, fu, q);
                r = mfma16(fw, fa, r);
                o = mfma16(frag_tr(iUh, CP, 16 * kt, 32 * ks, lane), fa, o); }
            const int kp = 16 * xt + fr; const float dep = __expf(fC[63 * CPF + kp] - fC[31 * CPF + kp]);
            f32x4 pv, qv, rv; const u32x2 rb2 = *(const LAS u32x2*)(iRp + (16 * xt + fr) * CP + 16 * kt + 4 * fq);
            const f32x4 rbar = {bf_lo(rb2.x), bf_hi(rb2.x), bf_lo(rb2.y), bf_hi(rb2.y)};
#pragma unroll
            for (int rg = 0; rg < 4; ++rg) { const float dlt = (kp == 16 * kt + 4 * fq + rg) ? 1.0f : 0.0f; pv[rg] = dep * (dlt - p[rg]) * dr4[rg]; qv[rg] = de4[rg] * (accQ[i][rg] - q[rg]); rv[rg] = (rbar[rg] - r[rg]) * dr4[rg]; }
            *(u32x2*)((bf16*)xs + kp * 64 + 16 * kt + 4 * fq) = pk4(pv);
            *(u32x2*)((bf16*)xs + 4096 + (16 * xt + fr) * 64 + 16 * kt + 4 * fq) = pk4(rv);
            *(u32x2*)((bf16*)xs + 8192 + (kt * 4 + xt) * 256 + lane * 4) = pk4(qv);
            *(u32x2*)((bf16*)xs + 12288 + (kt * 4 + xt) * 256 + lane * 4) = pk4(accO[i] - o); }
    }
    __syncthreads();
#undef SL
}
constexpr int Q_P = 0, Q_R = SLOT, Q_ZT = 2 * SLOT, Q_ZL = 3 * SLOT, Q_O = 4 * SLOT, Q_END = Q_O + ARRB;
__device__ __forceinline__ void rwkv_seq_item(Frame& F, int l, int b, int h) {
    const int tid = otid(), lane = tid & 63, wave = __builtin_amdgcn_readfirstlane(tid >> 6), fr = lane & 15, fq = lane >> 4;
    const int t = tid >> 3, j8 = tid & 7, ch = h * 64 + 8 * j8, kt = wave >> 1, vt0 = 2 * (wave & 1);
    LAS bf16* iP = (LAS bf16*)(F.lds + Q_P); LAS bf16* iR = (LAS bf16*)(F.lds + Q_R); LAS bf16* iZT = (LAS bf16*)(F.lds + Q_ZT); LAS bf16* iZL = (LAS bf16*)(F.lds + Q_ZL); LAS float* fO = (LAS float*)(F.lds + Q_O);
    float lnw[8], lnb[8];
#pragma unroll
    for (int i = 0; i < 8; ++i) { lnw[i] = kin<21>()[l * 256 + ch + i]; lnb[i] = kin<22>()[l * 256 + ch + i]; }
    f32x4 Z[2] = {{0.f, 0.f, 0.f, 0.f}, {0.f, 0.f, 0.f, 0.f}};
    const size_t unit0 = (size_t)(b * 4 + h) * (NT / 64);
    const unsigned char* xs = (const unsigned char*)F.out + unit0 * XS_UNIT; const unsigned char* xs2 = (const unsigned char*)F.out + XS2_OFF + unit0 * XS2_UNIT;
    v4u pP = *(const v4u*)(xs + tid * 16), pR = *(const v4u*)(xs + 8192 + tid * 16), pG = *(const v4u*)(xs2 + tid * 16), pE = *(const v4u*)(xs2 + 8192 + tid * 16);
    u32x2 pQ[2], pO[2];
#pragma unroll
    for (int i = 0; i < 2; ++i) { pQ[i] = *(const u32x2*)(xs + 16384 + ((kt * 4 + vt0 + i) * 256 + lane * 4) * 2); pO[i] = *(const u32x2*)(xs + 24576 + ((kt * 4 + vt0 + i) * 256 + lane * 4) * 2); }
    for (int c = 0; c < NT / 64; ++c) {
        *(LAS v4u*)(iP + (tid >> 3) * CP + (tid & 7) * 8) = pP; *(LAS v4u*)(iR + (tid >> 3) * CP + (tid & 7) * 8) = pR;
#pragma unroll
        for (int i = 0; i < 2; ++i) {
            const u32x2 hi = pk4(Z[i]); const f32x4 hf = {bf_lo(hi.x), bf_hi(hi.x), bf_lo(hi.y), bf_hi(hi.y)};
            *(LAS u32x2*)(iZT + (16 * (vt0 + i) + fr) * CP + 16 * kt + 4 * fq) = hi; *(LAS u32x2*)(iZL + (16 * (vt0 + i) + fr) * CP + 16 * kt + 4 * fq) = pk4(Z[i] - hf); }
        f32x4 q0[2], o0[2]; float gv[8], ev[8];
#pragma unroll
        for (int i = 0; i < 2; ++i) { q0[i] = (f32x4){bf_lo(pQ[i].x), bf_hi(pQ[i].x), bf_lo(pQ[i].y), bf_hi(pQ[i].y)}; o0[i] = (f32x4){bf_lo(pO[i].x), bf_hi(pO[i].x), bf_lo(pO[i].y), bf_hi(pO[i].y)}; }
        cvt_bf8(pG, gv); cvt_bf8(pE, ev);
        if (c + 1 < NT / 64) { const unsigned char* xn = xs + (size_t)(c + 1) * XS_UNIT; const unsigned char* xn2 = xs2 + (size_t)(c + 1) * XS2_UNIT;
            pP = *(const v4u*)(xn + tid * 16); pR = *(const v4u*)(xn + 8192 + tid * 16); pG = *(const v4u*)(xn2 + tid * 16); pE = *(const v4u*)(xn2 + 8192 + tid * 16);
#pragma unroll
            for (int i = 0; i < 2; ++i) { pQ[i] = *(const u32x2*)(xn + 16384 + ((kt * 4 + vt0 + i) * 256 + lane * 4) * 2); pO[i] = *(const u32x2*)(xn + 24576 + ((kt * 4 + vt0 + i) * 256 + lane * 4) * 2); } }
        __syncthreads();
#pragma unroll
        for (int i = 0; i < 2; ++i) {
            f32x4 o = o0[i], z = q0[i];
#pragma unroll
            for (int ks = 0; ks < 2; ++ks) { const bf16x8 fR = frag_rm(iR, CP, 16 * (vt0 + i), 32 * ks, lane), fP = frag_rm(iP, CP, 16 * kt, 32 * ks, lane);
                o = mfma16(frag_rm(iZT, CP, 16 * kt, 32 * ks, lane), fR, o); o = mfma16(frag_rm(iZL, CP, 16 * kt, 32 * ks, lane), fR, o);
                z = mfma16(fP, frag_rm(iZT, CP, 16 * (vt0 + i), 32 * ks, lane), z); z = mfma16(fP, frag_rm(iZL, CP, 16 * (vt0 + i), 32 * ks, lane), z); }
            *(LAS f32x4*)(fO + (16 * (vt0 + i) + fr) * CPF + 16 * kt + 4 * fq) = o; Z[i] = z; }
        __syncthreads();
        {
            const f32x4 a0 = *(const LAS f32x4*)(fO + t * CPF + 8 * j8), a1 = *(const LAS f32x4*)(fO + t * CPF + 8 * j8 + 4);
            const float mean = red8(((a0[0] + a0[1]) + (a0[2] + a0[3])) + ((a1[0] + a1[1]) + (a1[2] + a1[3]))) * (1.0f / 64.0f);
            const f32x4 d0 = a0 - mean, d1 = a1 - mean;
            const float var = red8(((d0[0] * d0[0] + d0[1] * d0[1]) + (d0[2] * d0[2] + d0[3] * d0[3])) + ((d1[0] * d1[0] + d1[1] * d1[1]) + (d1[2] * d1[2] + d1[3] * d1[3]))) * (1.0f / 64.0f);
            const float rs = __builtin_amdgcn_rsqf(var + 64e-5f); float y[8];
#pragma unroll
            for (int i = 0; i < 4; ++i) { y[i] = (d0[i] * rs * lnw[i] + lnb[i] + ev[i]) * gv[i]; y[4 + i] = (d1[i] * rs * lnw[4 + i] + lnb[4 + i] + ev[4 + i]) * gv[4 + i]; }
            v4u w; w.x = pk2(y[0], y[1]); w.y = pk2(y[2], y[3]); w.z = pk2(y[4], y[5]); w.w = pk2(y[6], y[7]);
            *(v4u*)(F.Y + ((size_t)b * NT + c * 64 + t) * D + 512 + ch) = w;
        }
    }
    __syncthreads();
}
constexpr int SC = 32;
constexpr int LA_BYTES = SC * 64 * 4;
constexpr int L_XW = 8 * LA_BYTES, L_XA = L_XW + SC * 144, L_XG = L_XA + SC * 144, L_W2T = L_XG + SC * 272, L_A2T = L_W2T + 64 * 144, L_G2T = L_A2T + 64 * 144, L_SCAN_END = L_G2T + 64 * 272;
static_assert(L_SCAN_END <= RING_BYTES, "scan LDS map");

__device__ __forceinline__ void scan_rwkv(const LAS float* W_, const LAS float* KK, const LAS float* KA, const LAS float* KX, const LAS float* R, const LAS float* V, LAS float* O, float (&S)[8], int wave, int lane) {
    const int ks = lane & 7, v = wave * 8 + (lane >> 3);
#pragma unroll 2
    for (int t = 0; t < SC; ++t) {
        const int o8 = t * 64 + ks * 8;
        const f32x4 w0 = *(const LAS f32x4*)(W_ + o8), w1 = *(const LAS f32x4*)(W_ + o8 + 4);
        const f32x4 c0 = *(const LAS f32x4*)(KK + o8), c1 = *(const LAS f32x4*)(KK + o8 + 4);
        const f32x4 e0 = *(const LAS f32x4*)(KA + o8), e1 = *(const LAS f32x4*)(KA + o8 + 4);
        const f32x4 k0 = *(const LAS f32x4*)(KX + o8), k1 = *(const LAS f32x4*)(KX + o8 + 4);
        const f32x4 r0 = *(const LAS f32x4*)(R + o8), r1 = *(const LAS f32x4*)(R + o8 + 4);
        const float vv = V[t * 64 + v];
        float d = 0.f;
#pragma unroll
        for (int j = 0; j < 4; ++j) d += S[j] * c0[j] + S[4 + j] * c1[j];
        d = red8(d);
        float o = 0.f;
#pragma unroll
        for (int j = 0; j < 4; ++j) { S[j] = S[j] * w0[j] + (vv * k0[j] - d * e0[j]); S[4 + j] = S[4 + j] * w1[j] + (vv * k1[j] - d * e1[j]); o += S[j] * r0[j] + S[4 + j] * r1[j]; }
        o = red8(o);
        if (ks == 0) O[t * 64 + v] = o;
    }
}

__device__ __forceinline__ void rwkv_item(Frame& F, const Args& A, int l, int b, int h) {
    LAS float* fW = (LAS float*)(F.lds + 0 * LA_BYTES); LAS float* fKK = (LAS float*)(F.lds + 1 * LA_BYTES); LAS float* fKA = (LAS float*)(F.lds + 2 * LA_BYTES); LAS float* fKX = (LAS float*)(F.lds + 3 * LA_BYTES);
    LAS float* fR = (LAS float*)(F.lds + 4 * LA_BYTES); LAS float* fV = (LAS float*)(F.lds + 5 * LA_BYTES); LAS float* fO = (LAS float*)(F.lds + 6 * LA_BYTES); LAS float* fG = (LAS float*)(F.lds + 7 * LA_BYTES);
    LAS bf16* sXW = (LAS bf16*)(F.lds + L_XW); LAS bf16* sXA = (LAS bf16*)(F.lds + L_XA); LAS bf16* sXG = (LAS bf16*)(F.lds + L_XG);
    LAS bf16* sW2 = (LAS bf16*)(F.lds + L_W2T); LAS bf16* sA2 = (LAS bf16*)(F.lds + L_A2T); LAS bf16* sG2 = (LAS bf16*)(F.lds + L_G2T);
    const int tid = otid(), lane = tid & 63, wave = __builtin_amdgcn_readfirstlane(tid >> 6), t = tid >> 4, j = tid & 15, ch = h * 64 + 4 * j;
    for (int i = tid; i < 64 * 64; i += NWAVES * 64) { const int k = i >> 6, n = i & 63;
        sW2[n * 72 + k] = (bf16)f2bf(kin<14>()[((size_t)l * 64 + k) * 256 + h * 64 + n]); sA2[n * 72 + k] = (bf16)f2bf(kin<16>()[((size_t)l * 64 + k) * 256 + h * 64 + n]); }
    for (int i = tid; i < 128 * 64; i += NWAVES * 64) { const int k = i >> 6, n = i & 63; sG2[n * 136 + k] = (bf16)f2bf(kin<17>()[((size_t)l * 128 + k) * 256 + h * 64 + n]); }
    const float* mu = kin<12>() + l * 1024;
    const f32x4 mu_r = *(const f32x4*)(mu + ch), mu_k = *(const f32x4*)(mu + 256 + ch), mu_v = *(const f32x4*)(mu + 512 + ch);
    const f32x4 mu_w = *(const f32x4*)(mu + 768 + 4 * j), mu_a = *(const f32x4*)(mu + 832 + 4 * j), mu_g0 = *(const f32x4*)(mu + 896 + 8 * j), mu_g1 = *(const f32x4*)(mu + 900 + 8 * j);
    const f32x4 c_kk = *(const f32x4*)(kin<18>() + l * 256 + ch), c_ka = *(const f32x4*)(kin<19>() + l * 256 + ch), c_rk = *(const f32x4*)(kin<20>() + l * 256 + ch);
    const f32x4 c_lw = *(const f32x4*)(kin<21>() + l * 256 + ch), c_lb = *(const f32x4*)(kin<22>() + l * 256 + ch);
    const int mt = wave >> 2, nt = wave & 3, fr = lane & 15, fq = lane >> 4;
    const float w0n = kin<13>()[l * 256 + h * 64 + nt * 16 + fr], a0n = kin<15>()[l * 256 + h * 64 + nt * 16 + fr];
    float S[8];
#pragma unroll
    for (int i = 0; i < 8; ++i) S[i] = 0.f;
    __syncthreads();
    for (int c = 0; c < NT / SC; ++c) {
        const int tpos = c * SC + t; const size_t row = (size_t)b * NT + tpos;
        const bf16* cur = F.HP + row * NP; const bf16* prv = (tpos > 0) ? cur - NP : cur; const float pm = (tpos > 0) ? 1.0f : 0.0f;
        {
            const bf16* ph = cur + PC_RW + h * 192 + 4 * j; const bf16* pp = prv + PC_RW + h * 192 + 4 * j;
            const f32x4 r = ld_bf4(ph), k = ld_bf4(ph + 64), v = ld_bf4(ph + 128);
            const f32x4 rp = ld_bf4(pp) * pm, kp = ld_bf4(pp + 64) * pm, vp = ld_bf4(pp + 128) * pm;
            *(LAS f32x4*)(fR + t * 64 + 4 * j) = r + (rp - r) * mu_r; *(LAS f32x4*)(fKX + t * 64 + 4 * j) = k + (kp - k) * mu_k; *(LAS f32x4*)(fV + t * 64 + 4 * j) = v + (vp - v) * mu_v;
            const f32x4 xw = ld_bf4(cur + PC_RWX + 4 * j), xwp = ld_bf4(prv + PC_RWX + 4 * j) * pm, xa = ld_bf4(cur + PC_RWX + 64 + 4 * j), xap = ld_bf4(prv + PC_RWX + 64 + 4 * j) * pm;
            const f32x4 sw = xw + (xwp - xw) * mu_w, sa = xa + (xap - xa) * mu_a;
            u32x2 u; u.x = pk2(tanh_f(sw[0]), tanh_f(sw[1])); u.y = pk2(tanh_f(sw[2]), tanh_f(sw[3])); *(LAS u32x2*)(sXW + t * 72 + 4 * j) = u;
            u.x = pk2(sa[0], sa[1]); u.y = pk2(sa[2], sa[3]); *(LAS u32x2*)(sXA + t * 72 + 4 * j) = u;
            const f32x4 g0 = ld_bf4(cur + PC_RWX + 128 + 8 * j), g1 = ld_bf4(cur + PC_RWX + 132 + 8 * j), g0p = ld_bf4(prv + PC_RWX + 128 + 8 * j) * pm, g1p = ld_bf4(prv + PC_RWX + 132 + 8 * j) * pm;
            const f32x4 s0 = g0 + (g0p - g0) * mu_g0, s1 = g1 + (g1p - g1) * mu_g1;
            v4u w; w.x = pk2(sigmoid_f(s0[0]), sigmoid_f(s0[1])); w.y = pk2(sigmoid_f(s0[2]), sigmoid_f(s0[3])); w.z = pk2(sigmoid_f(s1[0]), sigmoid_f(s1[1])); w.w = pk2(sigmoid_f(s1[2]), sigmoid_f(s1[3]));
            *(LAS v4u*)(sXG + t * 136 + 8 * j) = w;
        }
        __syncthreads();
        {
            f32x4 cw = {0.f, 0.f, 0.f, 0.f}, ca = cw, cg = cw;
#pragma unroll
            for (int ks = 0; ks < 2; ++ks) {
                cw = mfma16(*(const LAS bf16x8*)(sXW + (mt * 16 + fr) * 72 + ks * 32 + fq * 8), *(const LAS bf16x8*)(sW2 + (nt * 16 + fr) * 72 + ks * 32 + fq * 8), cw);
                ca = mfma16(*(const LAS bf16x8*)(sXA + (mt * 16 + fr) * 72 + ks * 32 + fq * 8), *(const LAS bf16x8*)(sA2 + (nt * 16 + fr) * 72 + ks * 32 + fq * 8), ca); }
#pragma unroll
            for (int ks = 0; ks < 4; ++ks) cg = mfma16(*(const LAS bf16x8*)(sXG + (mt * 16 + fr) * 136 + ks * 32 + fq * 8), *(const LAS bf16x8*)(sG2 + (nt * 16 + fr) * 136 + ks * 32 + fq * 8), cg);
            const int n = nt * 16 + fr;
#pragma unroll
            for (int rg = 0; rg < 4; ++rg) { const int tt = mt * 16 + fq * 4 + rg;
                fW[tt * 64 + n] = __expf(-0.6065306597f * sigmoid_f(w0n + cw[rg]));
                fO[tt * 64 + n] = sigmoid_f(a0n + ca[rg]);
                fG[tt * 64 + n] = cg[rg]; }
        }
        __syncthreads();
        {
            const f32x4 rk = *(const LAS f32x4*)(fKX + t * 64 + 4 * j), a = *(const LAS f32x4*)(fO + t * 64 + 4 * j);
            const f32x4 kr = rk * c_kk; const float n2 = red16((kr[0] * kr[0] + kr[1] * kr[1]) + (kr[2] * kr[2] + kr[3] * kr[3]));
            const float inv = 1.0f / fmaxf(sqrtf(n2), 1e-12f); const f32x4 kk = kr * inv;
            *(LAS f32x4*)(fKK + t * 64 + 4 * j) = kk; *(LAS f32x4*)(fKA + t * 64 + 4 * j) = kk * a;
            f32x4 kx;
#pragma unroll
            for (int i = 0; i < 4; ++i) kx[i] = rk[i] * (1.0f + (a[i] - 1.0f) * c_ka[i]);
            *(LAS f32x4*)(fKX + t * 64 + 4 * j) = kx;
        }
        __syncthreads();
        scan_rwkv(fW, fKK, fKA, fKX, fR, fV, fO, S, wave, lane);
        __syncthreads();
        {
            const f32x4 o = *(const LAS f32x4*)(fO + t * 64 + 4 * j), r = *(const LAS f32x4*)(fR + t * 64 + 4 * j), kx = *(const LAS f32x4*)(fKX + t * 64 + 4 * j);
            const f32x4 v = *(const LAS f32x4*)(fV + t * 64 + 4 * j), g = *(const LAS f32x4*)(fG + t * 64 + 4 * j);
            const float mean = red16((o[0] + o[1]) + (o[2] + o[3])) * (1.0f / 64.0f); const f32x4 dv = o - mean;
            const float var = red16((dv[0] * dv[0] + dv[1] * dv[1]) + (dv[2] * dv[2] + dv[3] * dv[3])) * (1.0f / 64.0f); const float rs = __builtin_amdgcn_rsqf(var + 64e-5f);
            const float bon = red16((r[0] * kx[0] * c_rk[0] + r[1] * kx[1] * c_rk[1]) + (r[2] * kx[2] * c_rk[2] + r[3] * kx[3] * c_rk[3]));
            f32x4 y;
#pragma unroll
            for (int i = 0; i < 4; ++i) y[i] = (dv[i] * rs * c_lw[i] + c_lb[i] + bon * v[i]) * g[i];
            st_bf4(F.Y + row * D + 512 + ch, y);
        }
        __syncthreads();
    }
}

constexpr int L_PX = 0, L_PL = 40960, L_PW = L_PL + 64 * 4 * 72 * 2, L_POOL_END = L_PW + 4 * 64 * 72 * 2;
static_assert(79 * 512 <= L_PL && L_POOL_END <= RING_BYTES, "pool LDS map");
__device__ __forceinline__ void pool_item(Frame& F, const Args& A, int l, int b, int c) {
    LAS bf16* PX = (LAS bf16*)(F.lds + L_PX); LAS bf16* PL = (LAS bf16*)(F.lds + L_PL); LAS bf16* PW = (LAS bf16*)(F.lds + L_PW);
    const int tid = otid(), lane = tid & 63, wave = __builtin_amdgcn_readfirstlane(tid >> 6), t0 = c * 64;
    for (int i = tid; i < 79 * 32; i += NWAVES * 64) { const int r = i >> 5, cc = i & 31, tok = t0 - 15 + r;
        v4u v = {0u, 0u, 0u, 0u}; if (tok >= 0) v = *(const v4u*)(F.HP + ((size_t)b * NT + tok) * NP + PC_POOL + cc * 8);
        *(LAS v4u*)(PX + r * 256 + cc * 8) = v; }
    const bf16* pw = (const bf16*)(F.ws + WS_POOLW) + (size_t)l * 16384;
    for (int i = tid; i < 4 * 64 * 8; i += NWAVES * 64) *(LAS v4u*)(PW + (i >> 3) * 72 + (i & 7) * 8) = *(const v4u*)(pw + i * 8);
    __syncthreads();
    {
        const int t = tid >> 3, g = (tid >> 1) & 3, half = tid & 1, w = 2 << g, col = g * 64 + half * 32;
        const int cntn = (t0 + t + 1 < w) ? (t0 + t + 1) : w; const float rc = 1.0f / (float)cntn;
        f32x4 acc[8];
#pragma unroll
        for (int q = 0; q < 8; ++q) acc[q] = (f32x4){0.f, 0.f, 0.f, 0.f};
        for (int s = 0; s < w; ++s) {
#pragma unroll
            for (int q = 0; q < 4; ++q) { const v4u u = *(const LAS v4u*)(PX + (15 + t - s) * 256 + col + 8 * q);
                acc[2 * q] += (f32x4){bf_lo(u.x), bf_hi(u.x), bf_lo(u.y), bf_hi(u.y)}; acc[2 * q + 1] += (f32x4){bf_lo(u.z), bf_hi(u.z), bf_lo(u.w), bf_hi(u.w)}; } }
#pragma unroll
        for (int q = 0; q < 4; ++q) { const v4u u = *(const LAS v4u*)(PX + (15 + t) * 256 + col + 8 * q);
            const f32x4 p0 = acc[2 * q] * rc - (f32x4){bf_lo(u.x), bf_hi(u.x), bf_lo(u.y), bf_hi(u.y)}, p1 = acc[2 * q + 1] * rc - (f32x4){bf_lo(u.z), bf_hi(u.z), bf_lo(u.w), bf_hi(u.w)};
            v4u o; o.x = pk2(p0[0], p0[1]); o.y = pk2(p0[2], p0[3]); o.z = pk2(p1[0], p1[1]); o.w = pk2(p1[2], p1[3]);
            *(LAS v4u*)(PL + (t * 4 + g) * 72 + half * 32 + 8 * q) = o; }
    }
    __syncthreads();
    {
        const int g = wave & 3, mh = wave >> 2, fr = lane & 15, fq = lane >> 4;
#pragma unroll
        for (int nt = 0; nt < 4; ++nt) { const f32x4 bb = *(const f32x4*)(kin<8>() + l * 256 + g * 64 + 16 * nt + 4 * fq), sc = *(const f32x4*)(kin<9>() + l * 256 + g * 64 + 16 * nt + 4 * fq);
#pragma unroll
            for (int mt = 0; mt < 2; ++mt) { const int tt = 2 * mh + mt; f32x4 acc = {0.f, 0.f, 0.f, 0.f};
#pragma unroll
                for (int ks = 0; ks < 2; ++ks) acc = mfma16(*(const LAS bf16x8*)(PW + (g * 64 + nt * 16 + fr) * 72 + ks * 32 + fq * 8), *(const LAS bf16x8*)(PL + ((16 * tt + fr) * 4 + g) * 72 + ks * 32 + fq * 8), acc);
                *(u32x2*)(F.Y + ((size_t)b * NT + t0 + 16 * tt + fr) * D + g * 64 + 16 * nt + 4 * fq) = pk4((acc + bb) * sc); } }
    }
    __syncthreads();
}
#ifndef RWKV_CHUNKED
#define RWKV_CHUNKED 1
#endif
__device__ __forceinline__ void mixer_phase(Frame& F, const Args& A, int l) {
    constexpr int NBIG = RWKV_CHUNKED ? 2 * NB * 4 : 3 * NB * 4, NRW = RWKV_CHUNKED ? NB * 4 * (NT / 64) : 0, NPOOL = NB * (NT / 64);
    constexpr int RW_SHARE = RWKV_CHUNKED ? 3 * 128 : 0;
    const int nbw = (F.G / 2 < NBIG) ? F.G / 2 : NBIG, g = blockIdx.x;
#if RWKV_CHUNKED
    rwkv_fill_tab(F, l, otid());
#endif
    if (g < nbw) {
        for (int it = g; it < NBIG; it += nbw) { const int mix = it >> 6, b = (it & 63) >> 2, h = it & 3;
            if (mix == 0) glalike_chunk_item<0>(F, l, b, h); else if (mix == 1) glalike_chunk_item<2>(F, l, b, h); else rwkv_item(F, A, l, b, h); }
#if RWKV_CHUNKED
        { RwPre pre; int it = NRW - RW_SHARE + g; if (it < NRW) rw_prefetch(F, it >> 7, (it >> 5) & 3, it & 31, otid(), pre);
          for (; it < NRW; it += nbw) { const int nx = it + nbw; rwkv_chunk_unit(F, l, it >> 7, (it >> 5) & 3, it & 31, pre, nx < NRW, nx >> 7, (nx >> 5) & 3, nx & 31); } }
#endif
    } else {
#if RWKV_CHUNKED
        { RwPre pre; int it = g - nbw; const int st = F.G - nbw, end = NRW - RW_SHARE; if (it < end) rw_prefetch(F, it >> 7, (it >> 5) & 3, it & 31, otid(), pre);
          for (; it < end; it += st) { const int nx = it + st; rwkv_chunk_unit(F, l, it >> 7, (it >> 5) & 3, it & 31, pre, nx < end, nx >> 7, (nx >> 5) & 3, nx & 31); } }
#endif
    }
}
__device__ __forceinline__ void mixer_phase2(Frame& F, const Args& A, int l) {
    const int nsw = RWKV_CHUNKED ? ((F.G / 2 < NB * 4) ? F.G / 2 : NB * 4) : 0, g = blockIdx.x;
    if (g < nsw) {
#if RWKV_CHUNKED
        for (int it = g; it < NB * 4; it += nsw) rwkv_seq_item(F, l, it >> 2, it & 3);
#endif
        return; }
    for (int it = g - nsw; it < NB * (NT / 64); it += F.G - nsw) pool_item(F, A, l, it >> 5, it & 31);
    const int tid = otid(), lane = tid & 63, wave = __builtin_amdgcn_readfirstlane(tid >> 6);
    const int gw = (g - nsw) * NWAVES + wave, NGW = (F.G - nsw) * NWAVES, c = 4 * lane;
    const f32x4 gn = *(const f32x4*)(kin<11>() + l * 256 + c);
    for (int m = gw; m < M; m += NGW) {
        bf16* yp = F.Y + (size_t)m * D + 256 + c; const f32x4 o = ld_bf4(yp);
        const float ms = wave_sum((o[0] * o[0] + o[1] * o[1]) + (o[2] * o[2] + o[3] * o[3])) * (1.0f / 256.0f); const float rs = __builtin_amdgcn_rsqf(ms + 1e-6f);
        const f32x4 hg = ld_bf4(F.HP + (size_t)m * NP + PC_HG + (c >> 6) * 256 + 192 + (c & 63)); f32x4 y;
#pragma unroll
        for (int i = 0; i < 4; ++i) y[i] = o[i] * rs * gn[i] * sigmoid_f(hg[i]);
        st_bf4(yp, y);
    }
    if (l == 0) convert_weights(F, A, 1, NL, (g - nsw) * NWAVES + wave, (F.G - nsw) * NWAVES);
}
__device__ __forceinline__ void final_norm(Frame& F, const Args& A) {
    const int tid = otid(), lane = tid & 63, wave = __builtin_amdgcn_readfirstlane(tid >> 6);
    const int gw = blockIdx.x * NWAVES + wave, NGW = F.G * NWAVES;
    f32x4 g[4];
#pragma unroll
    for (int j = 0; j < 4; ++j) g[j] = *((const f32x4*)kin<29>() + lane + 64 * j);
    for (int m = gw; m < M; m += NGW) { const float rs = pg8::row_rstd(F.SS, m); GAS f32x4* xr = (GAS f32x4*)(F.out + (size_t)m * D) + lane; const bf16* xb = F.XB + (size_t)m * D + 4 * lane;
#pragma unroll
        for (int j = 0; j < 4; ++j) xr[64 * j] = ld_bf4(xb + 256 * j) * rs * g[j]; }
}
#ifndef MK_N_LAUNCHES
#define MK_N_LAUNCHES 1
#endif
__global__ void __launch_bounds__(NWAVES * 64, 2) fwd(Args args) {
    extern __shared__ __attribute__((aligned(16))) unsigned char lds[];
    Frame F;
    F.lds = (LAS unsigned char*)lds; F.MISC = (volatile LAS unsigned*)(F.lds + MISC_OFF);
    F.G = gridDim.x; { const int bx = blockIdx.x; F.vcu = (F.G % 8 == 0) ? (bx % 8) * (F.G / 8) + bx / 8 : bx; }
    F.out = args.out; F.ws = args.ws; F.ctl = (gu32*)(args.ws + WS_CTL);
    F.XB = (bf16*)(args.ws + WS_XB); F.Y = (bf16*)(args.ws + WS_Y); F.HP = (bf16*)(args.ws + WS_HP); F.SS = (float*)(args.ws + WS_SS);
    for (int u = threadIdx.x; u < (LDS_BYTES - LDSCTL_OFF) / 4; u += NWAVES * 64) ((LAS unsigned*)(F.lds + LDSCTL_OFF))[u] = 0u;
    __syncthreads();
    const int lo = args.ph_lo, hi = args.ph_hi;
    XcdBarrier bar; bar.bar = (unsigned*)(F.ctl + CW_BAR); bar.x = 0; bar.st = nullptr;
    if (hi - lo > 1) bar = xcd_barrier_post((unsigned*)(F.ctl + CW_BAR), F.MISC + 8);
#define IN(k) (lo <= (k) && (k) < hi)
#ifndef PROBE_MASK
#define PROBE_MASK 0u
#endif
    unsigned long long pr_acc = 0ull, pr_t0 = (PROBE_MASK != 0u) ? __builtin_amdgcn_s_memrealtime() : 0ull;
#define PSPAN(k) do { if (PROBE_MASK != 0u) { const unsigned long long _t = __builtin_amdgcn_s_memrealtime(); if ((PROBE_MASK >> (k)) & 1u) pr_acc += _t - pr_t0; pr_t0 = _t; } } while (0)
#define SEAM(k) do { if (IN(k) && IN((k) + 1)) xcd_barrier(bar); } while (0)
#ifndef PHMASK
#define PHMASK 0xFFFF
#endif
#define PHEN(k) ((PHMASK >> (k)) & 1)
    if (PHEN(0) && IN(0)) p0_prologue(F, args);
    SEAM(0); PSPAN(0);
    for (int l = 0; l < NL; ++l) {
        const int pb = 1 + 8 * l;
        const unsigned char* wl = args.ws + WS_W + (size_t)l * W_LAYER;
        if (PHEN(1) && IN(pb + 0)) {
            pg8::Gemm g{F.XB, (const bf16*)(wl + WO_1IN), M, 2 * DFF, D}; pg8::StaticOrder S; S.init(M, 2 * DFF, F.G, (int)blockIdx.x);
            pg8::EpiSwiGLU E{F.HP, DFF, F.SS, (const LAS float*)(F.lds + RING_OFF + pg8::STAGE_BYTES)};
            pg8::gemm_phase<pg8::EpiSwiGLU, pg8::StaticOrder, true, true>(F.lds + RING_OFF, g, S, E); }
        SEAM(pb + 0); PSPAN(pb + 0);
        if (PHEN(2) && IN(pb + 1)) {
            pg8::Gemm g{F.HP, (const bf16*)(wl + WO_1OUT), M, D, DFF}; pg8::StaticOrder S; S.init(M, D, F.G, (int)blockIdx.x);
            pg8::EpiResid E{F.XB, F.SS, 0.5f};
            pg8::gemm_phase<pg8::EpiResid, pg8::StaticOrder, true, true>(F.lds + RING_OFF, g, S, E); }
        SEAM(pb + 1); PSPAN(pb + 1);
        if (PHEN(3) && IN(pb + 2)) {
            pg8::Gemm g{F.XB, (const bf16*)(wl + WO_IN), M, NP, D}; pg8::StaticOrder S; S.init(M, NP, F.G, (int)blockIdx.x);
            pg8::EpiScale E{F.HP, NP, F.SS, (const LAS float*)(F.lds + RING_OFF + pg8::STAGE_BYTES)};
            pg8::gemm_phase<pg8::EpiScale, pg8::StaticOrder, true, true>(F.lds + RING_OFF, g, S, E); }
        SEAM(pb + 2); PSPAN(pb + 2);
        if (PHEN(4) && IN(pb + 3)) mixer_phase(F, args, l);
        SEAM(pb + 3); PSPAN(pb + 3);
        if (PHEN(5) && IN(pb + 4)) mixer_phase2(F, args, l);
        SEAM(pb + 4); PSPAN(pb + 4);
        if (PHEN(6) && IN(pb + 5)) {
            pg8::Gemm g{F.Y, (const bf16*)(wl + WO_OUT), M, D, D}; pg8::StaticOrder S; S.init(M, D, F.G, (int)blockIdx.x);
            pg8::EpiResid E{F.XB, F.SS, 1.0f};
            pg8::gemm_phase<pg8::EpiResid, pg8::StaticOrder, true, true>(F.lds + RING_OFF, g, S, E); }
        SEAM(pb + 5); PSPAN(pb + 5);
        if (PHEN(7) && IN(pb + 6)) {
            pg8::Gemm g{F.XB, (const bf16*)(wl + WO_2IN), M, 2 * DFF, D}; pg8::StaticOrder S; S.init(M, 2 * DFF, F.G, (int)blockIdx.x);
            pg8::EpiSwiGLU E{F.HP, DFF, F.SS, (const LAS float*)(F.lds + RING_OFF + pg8::STAGE_BYTES)};
            pg8::gemm_phase<pg8::EpiSwiGLU, pg8::StaticOrder, true, true>(F.lds + RING_OFF, g, S, E); }
        SEAM(pb + 6); PSPAN(pb + 6);
        if (PHEN(8) && IN(pb + 7)) {
            pg8::Gemm g{F.HP, (const bf16*)(wl + WO_2OUT), M, D, DFF}; pg8::StaticOrder S; S.init(M, D, F.G, (int)blockIdx.x);
            pg8::EpiResid E{F.XB, F.SS, 0.5f};
            pg8::gemm_phase<pg8::EpiResid, pg8::StaticOrder, true, true>(F.lds + RING_OFF, g, S, E); }
        SEAM(pb + 7); PSPAN(pb + 7);
    }
    if (PHEN(9) && IN(17)) final_norm(F, args);
    PSPAN(17);
    if (PROBE_MASK != 0u && blockIdx.x == 0) { const unsigned long long _e = __builtin_amdgcn_s_memrealtime(); while (__builtin_amdgcn_s_memrealtime() - _e < pr_acc) __builtin_amdgcn_s_sleep(8); }
#undef IN
#undef SEAM
}

extern "C" void kernel_launch(void* const* d_in, const int* in_sizes, int n_in, void* d_out, int out_size, void* d_ws, size_t ws_size, hipStream_t stream) {
    static int grid = 0;
    if (grid == 0) {
        if (n_in != 30 || in_sizes[0] != M * D || out_size != M * D || ws_size < WS_END) { fprintf(stderr, "kernel_launch: built for 30 inputs, x/out of %d floats, >= %zu bytes of workspace; got n_in %d, in0 %d, out %d, ws %zu; nothing launched\n", M * D, (size_t)WS_END, n_in, n_in > 0 ? in_sizes[0] : -1, out_size, ws_size); grid = -1; return; }
        int dev = 0, cus = 0, per_cu = 0;
        if (hipGetDevice(&dev) != hipSuccess || hipDeviceGetAttribute(&cus, hipDeviceAttributeMultiprocessorCount, dev) != hipSuccess) { fprintf(stderr, "kernel_launch: device query failed\n"); grid = -1; return; }
        if (hipFuncSetAttribute((const void*)fwd, hipFuncAttributeMaxDynamicSharedMemorySize, LDS_BYTES) != hipSuccess) { fprintf(stderr, "kernel_launch: hipFuncSetAttribute failed\n"); grid = -1; return; }
        if (hipOccupancyMaxActiveBlocksPerMultiprocessor(&per_cu, (const void*)fwd, NWAVES * 64, LDS_BYTES) != hipSuccess || per_cu < 1)
            fprintf(stderr, "kernel_launch: note: occupancy query reports %d workgroups per CU\n", per_cu);
        (void)hipGetLastError();
        grid = cus;
    }
    if (grid < 0) return;
    if (hipMemsetAsync((char*)d_ws + WS_CTL, 0, CTL_ZERO_BYTES, stream) != hipSuccess) { fprintf(stderr, "kernel_launch: memset failed\n"); return; }
    Args a{};
    for (int i = 0; i < 30; ++i) a.in[i] = (const float*)d_in[i];
    a.out = (float*)d_out; a.ws = (unsigned char*)d_ws;
    if (MK_N_LAUNCHES == 1) { a.ph_lo = 0; a.ph_hi = N_PHASES; hipLaunchKernelGGL(fwd, dim3(grid), dim3(NWAVES * 64), LDS_BYTES, stream, a); }
    else for (int k = 0; k < N_PHASES; ++k) { a.ph_lo = k; a.ph_hi = k + 1; hipLaunchKernelGGL(fwd, dim3(grid), dim3(NWAVES * 64), LDS_BYTES, stream, a); }
    const hipError_t le = hipPeekAtLastError();
    if (le != hipSuccess) fprintf(stderr, "kernel_launch: launch failed: %s\n", hipGetErrorName(le));
}
```
